# Optimizing an MI355X kernel written in HIP

```python
import math
import jax, jax.numpy as jnp
from jax import lax
import numpy as np

D_MODEL = 2048
BATCH = 1
SEQ = 16384
DEPTH = 1

GRID_W = 64
NA_HEADS = 8
NA_HEAD_DIM = 128
NA_WIDTH = NA_HEADS * NA_HEAD_DIM
NA_MAX_ROWS = 8
NA_COLS = 16
S5_GROUP = 16
S5_GROUPS = 64
S5_WIDTH = S5_GROUP * S5_GROUPS
S5_STATE = 64
D_FF = 256 * (-(-8 * D_MODEL // (3 * 256)))
IN_COLS = 3 * NA_WIDTH + S5_WIDTH + 2 * D_MODEL
LN_EPS = 1e-5
DEEPNORM_ALPHA = (2.0 * DEPTH) ** 0.25
DEEPNORM_BETA = (8.0 * DEPTH) ** -0.25

kernel_name = "hybrid_natten_s5_gated_deepnorm"


def _layer_norm(x, g, b):
    xf = x.astype(jnp.float32)
    mu = jnp.mean(xf, axis=-1, keepdims=True)
    var = jnp.mean(jnp.square(xf - mu), axis=-1, keepdims=True)
    y = (xf - mu) * lax.rsqrt(var + LN_EPS) * g.astype(jnp.float32) + b.astype(jnp.float32)
    return y.astype(x.dtype)


def _neighbourhood_attention(q, k, v, rpb):
    bsz, seq = q.shape[0], q.shape[1]
    rows = seq // GRID_W
    kh = min(NA_MAX_ROWS, rows)
    kw = NA_COLS
    grid = lambda t: t.reshape(bsz, rows, GRID_W, NA_HEADS, NA_HEAD_DIM)
    qg, kg, vg = grid(q), grid(k), grid(v)
    cols = jnp.arange(GRID_W)
    col_start = jnp.clip(cols - kw // 2, 0, GRID_W - kw)
    col_mask = (cols[None, :] >= col_start[:, None]) & (cols[None, :] < col_start[:, None] + kw)
    col_idx = jnp.clip(cols[None, :] - cols[:, None], -(kw - 1), kw - 1) + (NA_COLS - 1)
    rpb32 = rpb.astype(jnp.float32)
    scale = NA_HEAD_DIM ** -0.5

    def row_block(r):
        r0 = jnp.clip(r - kh // 2, 0, rows - kh)
        q_r = lax.dynamic_index_in_dim(qg, r, axis=1, keepdims=False)
        k_b = lax.dynamic_slice_in_dim(kg, r0, kh, axis=1)
        v_b = lax.dynamic_slice_in_dim(vg, r0, kh, axis=1)
        s = jnp.einsum("bqhd,bikhd->bhqik", q_r, k_b).astype(jnp.float32) * scale
        row_idx = r0 + jnp.arange(kh) - r + (NA_MAX_ROWS - 1)
        bias = rpb32[:, row_idx][:, :, col_idx].transpose(0, 2, 1, 3)
        s = jnp.where(col_mask[None, None, :, None, :], s + bias[None], -1e30)
        p = jax.nn.softmax(s.reshape(bsz, NA_HEADS, GRID_W, kh * GRID_W), axis=-1)
        p = p.reshape(s.shape).astype(v.dtype)
        return jnp.einsum("bhqik,bikhd->bqhd", p, v_b)

    out = lax.map(row_block, jnp.arange(rows))
    return out.transpose(1, 0, 2, 3, 4).reshape(bsz, seq, NA_WIDTH)


def _s5_scan(u, a_re, a_im, log_dt, b_re, b_im, c_re, c_im, reverse):
    f32 = jnp.float32
    lam = lax.complex(a_re.astype(f32), a_im.astype(f32))
    dt = jnp.exp(log_dt.astype(f32))[:, None]
    lam_bar = jnp.exp(lam * dt)
    b = lax.complex(b_re.astype(f32), b_im.astype(f32))
    b_bar = ((lam_bar - 1.0) / lam)[..., None] * b
    bu = jnp.einsum("blgc,gpc->blgp", u.astype(jnp.complex64), b_bar)
    a = jnp.broadcast_to(lam_bar, bu.shape)

    def combine(e1, e2):
        a1, s1 = e1
        a2, s2 = e2
        return a1 * a2, a2 * s1 + s2

    _, states = lax.associative_scan(combine, (a, bu), reverse=reverse, axis=1)
    return (jnp.einsum("blgp,gcp->blgc", states.real, c_re.astype(f32))
            - jnp.einsum("blgp,gcp->blgc", states.imag, c_im.astype(f32)))


def setup_inputs(seed: int = 0) -> dict:
    key = jax.random.key(seed)
    ks = jax.random.split(key, 32)
    f32 = jnp.float32
    L = DEPTH
    nrm = lambda k, shape, sc: jax.random.normal(k, shape, f32) * sc
    n = jnp.arange(S5_STATE, dtype=f32)
    return {
        "x": nrm(ks[0], (BATCH, SEQ, D_MODEL), 1.0),
        "w_in": nrm(ks[1], (L, D_MODEL, IN_COLS), D_MODEL ** -0.5),
        "b_gate": nrm(ks[2], (L, 2 * D_MODEL), 0.02),
        "na_rpb": nrm(ks[3], (L, NA_HEADS, 2 * NA_MAX_ROWS - 1, 2 * NA_COLS - 1), 0.1),
        "w_na_out": nrm(ks[4], (L, NA_WIDTH, D_MODEL), NA_WIDTH ** -0.5),
        "s5_a_re": -0.5 + nrm(ks[5], (L, 2, S5_GROUPS, S5_STATE), 0.01),
        "s5_a_im": math.pi * n + nrm(ks[6], (L, 2, S5_GROUPS, S5_STATE), 0.01),
        "s5_log_dt": jax.random.uniform(ks[7], (L, 2, S5_GROUPS), f32, math.log(1e-3), math.log(1e-1)),
        "s5_b_re": nrm(ks[8], (L, 2, S5_GROUPS, S5_STATE, S5_GROUP), (2 * S5_GROUP) ** -0.5),
        "s5_b_im": nrm(ks[9], (L, 2, S5_GROUPS, S5_STATE, S5_GROUP), (2 * S5_GROUP) ** -0.5),
        "s5_c_re": nrm(ks[10], (L, 2, S5_GROUPS, S5_GROUP, S5_STATE), (2 * S5_STATE) ** -0.5),
        "s5_c_im": nrm(ks[11], (L, 2, S5_GROUPS, S5_GROUP, S5_STATE), (2 * S5_STATE) ** -0.5),
        "s5_d": nrm(ks[12], (L, S5_GROUPS, S5_GROUP), 1.0),
        "w_glu": nrm(ks[13], (L, S5_WIDTH, S5_WIDTH), S5_WIDTH ** -0.5),
        "b_glu": nrm(ks[14], (L, S5_WIDTH), 0.02),
        "w_s5_out": nrm(ks[15], (L, S5_WIDTH, D_MODEL), S5_WIDTH ** -0.5),
        "w_out": nrm(ks[16], (L, D_MODEL, D_MODEL), DEEPNORM_BETA * D_MODEL ** -0.5),
        "ln1_g": 1.0 + nrm(ks[17], (L, D_MODEL), 0.02),
        "ln1_b": nrm(ks[18], (L, D_MODEL), 0.02),
        "w_ffn_gate": nrm(ks[19], (L, D_MODEL, D_FF), D_MODEL ** -0.5),
        "w_ffn_up": nrm(ks[20], (L, D_MODEL, D_FF), D_MODEL ** -0.5),
        "w_ffn_down": nrm(ks[21], (L, D_FF, D_MODEL), DEEPNORM_BETA * D_FF ** -0.5),
        "ln2_g": 1.0 + nrm(ks[22], (L, D_MODEL), 0.02),
        "ln2_b": nrm(ks[23], (L, D_MODEL), 0.02),
    }


def reference(x, w_in, b_gate, na_rpb, w_na_out, s5_a_re, s5_a_im, s5_log_dt, s5_b_re, s5_b_im,
              s5_c_re, s5_c_im, s5_d, w_glu, b_glu, w_s5_out, w_out, ln1_g, ln1_b,
              w_ffn_gate, w_ffn_up, w_ffn_down, ln2_g, ln2_b):
    bsz, seq, _ = x.shape
    splits = [NA_WIDTH, 2 * NA_WIDTH, 3 * NA_WIDTH, 3 * NA_WIDTH + S5_WIDTH,
              3 * NA_WIDTH + S5_WIDTH + D_MODEL]
    for l in range(DEPTH):
        proj = x @ w_in[l]
        q, k, v, u, g_att, g_ssm = jnp.split(proj, splits, axis=-1)
        g_att = jax.nn.sigmoid(g_att + b_gate[l, :D_MODEL])
        g_ssm = jax.nn.sigmoid(g_ssm + b_gate[l, D_MODEL:])

        heads = lambda t: t.reshape(bsz, seq, NA_HEADS, NA_HEAD_DIM)
        y_att = _neighbourhood_attention(heads(q), heads(k), heads(v), na_rpb[l]) @ w_na_out[l]

        ug = u.astype(jnp.float32).reshape(bsz, seq, S5_GROUPS, S5_GROUP)
        y_f = _s5_scan(ug, s5_a_re[l, 0], s5_a_im[l, 0], s5_log_dt[l, 0], s5_b_re[l, 0], s5_b_im[l, 0],
                       s5_c_re[l, 0], s5_c_im[l, 0], reverse=False)
        y_b = _s5_scan(ug, s5_a_re[l, 1], s5_a_im[l, 1], s5_log_dt[l, 1], s5_b_re[l, 1], s5_b_im[l, 1],
                       s5_c_re[l, 1], s5_c_im[l, 1], reverse=True)
        y_s = (y_f + y_b + s5_d[l].astype(jnp.float32) * ug).reshape(bsz, seq, S5_WIDTH).astype(x.dtype)
        y_s = jax.nn.gelu(y_s)
        y_s = y_s * jax.nn.sigmoid(y_s @ w_glu[l] + b_glu[l])
        y_ssm = y_s @ w_s5_out[l]

        mix = (g_att * y_att + g_ssm * y_ssm) @ w_out[l]
        h = _layer_norm(DEEPNORM_ALPHA * x + mix, ln1_g[l], ln1_b[l])

        ff = (jax.nn.silu(h @ w_ffn_gate[l]) * (h @ w_ffn_up[l])) @ w_ffn_down[l]
        x = _layer_norm(DEEPNORM_ALPHA * h + ff, ln2_g[l], ln2_b[l])
    return x
```

```cpp
#include <hip/hip_runtime.h>
#include <hip/hip_cooperative_groups.h>
#include <cstdio>
#include <cstdint>
namespace cg = cooperative_groups;
namespace pg8 {
#define PG8_LAS __attribute__((address_space(3)))
typedef unsigned short bf16_t;
typedef short bf16x8 __attribute__((ext_vector_type(8)));
typedef float f32x4 __attribute__((ext_vector_type(4)));
typedef unsigned u32x4 __attribute__((ext_vector_type(4)));
constexpr int BM = 256, BK = 64, HALF = 128, HTB = HALF * BK * 2  , STAGE_BYTES = 8 * HTB, NXCD = 8, WGM = 8;

__host__ __device__ __forceinline__ int lds_byte(int r, int c) { const int st = (r >> 4) * 2 + (c >> 5), rr = r & 15, cc = c & 31, ob = rr * 64 + cc * 2; return st * 1024 + (ob ^ (((ob >> 9) & 1) << 5)); }
__host__ __device__ __forceinline__ void stage_rc(int b, int& R, int& C) { const int st = b / 1024, sb = b % 1024, swz = sb ^ (((sb >> 9) & 1) << 5); R = (st >> 1) * 16 + swz / 64; C = (st & 1) * 32 + (swz % 64) / 2; }
__host__ __device__ __forceinline__ int perm32(int rho) { const int n = rho >> 4, i = rho & 15; return 8 * (i >> 2) + 4 * n + (i & 3); }

struct Unit { int pm, pn, gi; };
struct Gemm { const bf16_t* A; const bf16_t* Bt; int M, N, K; const bf16_t* A2 = nullptr; const bf16_t* Bt2 = nullptr; };

struct StaticOrder {
    int nM, nN, nwg, G, c, wgm, swp;
    __host__ __device__ void init(int M, int N, int G_, int c_, int wgm_ = WGM, int swp_ = 0) { nM = M / BM; nN = N / BM; nwg = nM * nN; G = G_; c = c_; wgm = wgm_; swp = swp_; }
    __host__ __device__ bool next(int i, Unit& u) const { const long L = (long)i * G + c; if (L >= nwg) return false; at(L, u); return true; }
    __host__ __device__ void at(long L, Unit& u) const {
        u.gi = 0;
        int wgid = (int)L; { const int q = nwg / NXCD, r = nwg % NXCD, xcd = wgid % NXCD, off = wgid / NXCD; wgid = (xcd < r ? xcd * (q + 1) : r * (q + 1) + (xcd - r) * q) + off; }
        const int rM = swp ? nN : nM, rN = swp ? nM : nN;
        const int nig = wgm * rN, gid = wgid / nig, fm = gid * wgm, gsz = (rM - fm) < wgm ? (rM - fm) : wgm;
        const int ta = fm + ((wgid % nig) % gsz), tb = (wgid % nig) / gsz;
        u.pm = swp ? tb : ta; u.pn = swp ? ta : tb;
    }
    __device__ __forceinline__ void a_ready(const Unit&) const {}
    __device__ __forceinline__ void done(const Unit&) const {}
};


typedef __bf16 bf16x2_t __attribute__((ext_vector_type(2)));
typedef float f32x2_t __attribute__((ext_vector_type(2)));
__device__ __forceinline__ unsigned cvt_pk_bf16(float lo, float hi) { f32x2_t f = {lo, hi}; bf16x2_t b = __builtin_convertvector(f, bf16x2_t); return __builtin_bit_cast(unsigned, b); }
__device__ __forceinline__ float bf_lo(unsigned w) { return __uint_as_float(w << 16); }
__device__ __forceinline__ float bf_hi(unsigned w) { return __uint_as_float(w & 0xffff0000u); }
__device__ __forceinline__ float sigm(float v) { return __builtin_amdgcn_rcpf(1.0f + __builtin_amdgcn_exp2f(v * -1.44269504089f)); }
__device__ __forceinline__ u32x4 pack8(const f32x4 v0, const f32x4 v1) { u32x4 w; w.x = cvt_pk_bf16(v0[0], v0[1]); w.y = cvt_pk_bf16(v0[2], v0[3]); w.z = cvt_pk_bf16(v1[0], v1[1]); w.w = cvt_pk_bf16(v1[2], v1[3]); return w; }
__device__ __forceinline__ void unpack8(const u32x4 w, f32x4& v0, f32x4& v1) { v0 = (f32x4){bf_lo(w.x), bf_hi(w.x), bf_lo(w.y), bf_hi(w.y)}; v1 = (f32x4){bf_lo(w.z), bf_hi(w.z), bf_lo(w.w), bf_hi(w.w)}; }

__device__ __forceinline__ unsigned cvt_pk_q16(float lo, float hi) { return __builtin_bit_cast(unsigned, __builtin_amdgcn_cvt_pknorm_i16(lo * 0.03125f, hi * 0.03125f)); }
__device__ __forceinline__ u32x4 pack8h(const f32x4 v0, const f32x4 v1) { u32x4 w; w.x = cvt_pk_q16(v0[0], v0[1]); w.y = cvt_pk_q16(v0[2], v0[3]); w.z = cvt_pk_q16(v1[0], v1[1]); w.w = cvt_pk_q16(v1[2], v1[3]); return w; }
__device__ __forceinline__ float q_lo(unsigned w) { return (float)(short)(w & 0xffffu) * (32.0f / 32767.0f); }
__device__ __forceinline__ float q_hi(unsigned w) { return (float)((int)w >> 16) * (32.0f / 32767.0f); }
__device__ __forceinline__ void unpack8h(const u32x4 w, f32x4& v0, f32x4& v1) { v0 = (f32x4){q_lo(w.x), q_hi(w.x), q_lo(w.y), q_hi(w.y)}; v1 = (f32x4){q_lo(w.z), q_hi(w.z), q_lo(w.w), q_hi(w.w)}; }

struct PairOrder {
    StaticOrder s;
    __host__ __device__ bool next(int i, Unit& u) const { const long L = (long)(i >> 1) * s.G + s.c; if (L >= s.nwg) return false; s.at(L, u); u.gi = i & 1; return true; }
    __device__ __forceinline__ void a_ready(const Unit&) const {}
    __device__ __forceinline__ void done(const Unit&) const {}
};
typedef unsigned u32x2 __attribute__((ext_vector_type(2)));
__device__ __forceinline__ unsigned q8(float v) { return (unsigned)(v * 255.0f + 0.5f); }
__device__ __forceinline__ u32x2 pack8g(const f32x4 v0, const f32x4 v1) { u32x2 w; w.x = q8(v0[0]) | (q8(v0[1]) << 8) | (q8(v0[2]) << 16) | (q8(v0[3]) << 24); w.y = q8(v1[0]) | (q8(v1[1]) << 8) | (q8(v1[2]) << 16) | (q8(v1[3]) << 24); return w; }
__device__ __forceinline__ void unpack8g(const u32x2 w, f32x4& v0, f32x4& v1) { const float k = 1.0f / 255.0f;
    v0 = (f32x4){(float)(w.x & 0xffu) * k, (float)((w.x >> 8) & 0xffu) * k, (float)((w.x >> 16) & 0xffu) * k, (float)(w.x >> 24) * k};
    v1 = (f32x4){(float)(w.y & 0xffu) * k, (float)((w.y >> 8) & 0xffu) * k, (float)((w.y >> 16) & 0xffu) * k, (float)(w.y >> 24) * k}; }

#define EPI_PIECE(c) const int ai = (c) >> 3, m = ((c) >> 1) & 3, bj = (c) & 1; const size_t row = (size_t)(u.pm * BM + ai * HALF + wr * 64 + m * 16 + fr); const int cin = bj * HALF + wc * 32 + 8 * fq; (void)row; (void)cin;
#define EPI_FENCE() asm volatile("" ::: "memory")

struct EpiPlain {
    static constexpr bool PERM = true, AFTER_DRAIN = false, CHAIN = false;
    bf16_t* O; int ldc;
    __device__ __forceinline__ void operator()(const f32x4 (&acc)[2][2][4][2], const Unit& u, int wr, int wc, int fr, int fq) const {
#pragma unroll
        for (int c = 0; c < 16; ++c) { EPI_PIECE(c) *(u32x4*)(O + row * ldc + u.pn * BM + cin) = pack8(acc[ai][bj][m][0], acc[ai][bj][m][1]); }
    }
};
struct EpiProj {
    static constexpr bool PERM = true, AFTER_DRAIN = false, CHAIN = false;
    bf16_t *Q, *K, *U; unsigned char *GA, *GS; const float* bgate; float qscale;
    __device__ __forceinline__ void operator()(const f32x4 (&acc)[2][2][4][2], const Unit& u, int wr, int wc, int fr, int fq) const {
        const int pn = u.pn; bf16_t* base = Q; unsigned char* gbase = GA; int ldc, colt; float sc = 1.0f; bool gate = false;
        if (pn < 4) { base = Q; ldc = 1024; colt = pn * BM; sc = qscale; }
        else if (pn < 8) { base = K; ldc = 1024; colt = (pn - 4) * BM; }
        else if (pn < 12) { base = U; ldc = 1024; colt = (pn - 8) * BM; }
        else if (pn < 20) { gbase = GA; ldc = 2048; colt = (pn - 12) * BM; gate = true; }
        else { gbase = GS; ldc = 2048; colt = (pn - 20) * BM; gate = true; }
        const float* bp = bgate + (pn >= 12 ? (pn - 12) * BM : 0) + wc * 32 + 8 * fq;
        f32x4 bv[2][2];
#pragma unroll
        for (int bj = 0; bj < 2; ++bj) { bv[bj][0] = gate ? *(const f32x4*)(bp + bj * HALF) : (f32x4){0.f, 0.f, 0.f, 0.f}; bv[bj][1] = gate ? *(const f32x4*)(bp + bj * HALF + 4) : (f32x4){0.f, 0.f, 0.f, 0.f}; }
        EPI_FENCE();
#pragma unroll
        for (int c = 0; c < 16; ++c) { EPI_PIECE(c)
            f32x4 v0 = acc[ai][bj][m][0], v1 = acc[ai][bj][m][1];
            if (gate) { v0 = v0 + bv[bj][0]; v1 = v1 + bv[bj][1];
                v0 = (f32x4){sigm(v0[0]), sigm(v0[1]), sigm(v0[2]), sigm(v0[3])}; v1 = (f32x4){sigm(v1[0]), sigm(v1[1]), sigm(v1[2]), sigm(v1[3])};
                __builtin_nontemporal_store(pack8g(v0, v1), (u32x2*)(gbase + row * ldc + colt + cin)); }
            else { v0 = v0 * sc; v1 = v1 * sc; *(u32x4*)(base + row * ldc + colt + cin) = pack8(v0, v1); } }
    }
};
struct EpiGlu {
    static constexpr bool PERM = true, AFTER_DRAIN = false, CHAIN = false;
    const bf16_t* Y; bf16_t* O; int ldc; const float* bias;
    __device__ __forceinline__ void operator()(const f32x4 (&acc)[2][2][4][2], const Unit& u, int wr, int wc, int fr, int fq) const {
        f32x4 bv[2][2]; u32x4 yw[16];
#pragma unroll
        for (int bj = 0; bj < 2; ++bj) { const float* bp = bias + u.pn * BM + bj * HALF + wc * 32 + 8 * fq; bv[bj][0] = *(const f32x4*)bp; bv[bj][1] = *(const f32x4*)(bp + 4); }
#pragma unroll
        for (int c = 0; c < 16; ++c) { EPI_PIECE(c) yw[c] = *(const u32x4*)(Y + row * ldc + u.pn * BM + cin); }
        EPI_FENCE();
#pragma unroll
        for (int c = 0; c < 16; ++c) { EPI_PIECE(c)
            f32x4 y0, y1; unpack8(yw[c], y0, y1);
            f32x4 v0 = acc[ai][bj][m][0] + bv[bj][0], v1 = acc[ai][bj][m][1] + bv[bj][1];
            v0 = (f32x4){y0[0] * sigm(v0[0]), y0[1] * sigm(v0[1]), y0[2] * sigm(v0[2]), y0[3] * sigm(v0[3])};
            v1 = (f32x4){y1[0] * sigm(v1[0]), y1[1] * sigm(v1[1]), y1[2] * sigm(v1[2]), y1[3] * sigm(v1[3])};
            *(u32x4*)(O + row * ldc + u.pn * BM + cin) = pack8(v0, v1); }
    }
};
struct EpiMixA {
    static constexpr bool PERM = true, AFTER_DRAIN = false, CHAIN = false;
    const unsigned char* G; bf16_t* T; int ldc;
    __device__ __forceinline__ void operator()(const f32x4 (&acc)[2][2][4][2], const Unit& u, int wr, int wc, int fr, int fq) const {
        u32x2 gw[16];
#pragma unroll
        for (int c = 0; c < 16; ++c) { EPI_PIECE(c) gw[c] = *(const u32x2*)(G + row * ldc + u.pn * BM + cin); }
        EPI_FENCE();
#pragma unroll
        for (int c = 0; c < 16; ++c) { EPI_PIECE(c)
            f32x4 g0, g1; unpack8g(gw[c], g0, g1);
            *(u32x4*)(T + row * ldc + u.pn * BM + cin) = pack8(g0 * acc[ai][bj][m][0], g1 * acc[ai][bj][m][1]); }
    }
};
struct EpiMixB {
    static constexpr bool PERM = true, AFTER_DRAIN = false, CHAIN = false;
    const unsigned char* G; const bf16_t* T; bf16_t* O; int ldc;
    __device__ __forceinline__ void operator()(const f32x4 (&acc)[2][2][4][2], const Unit& u, int wr, int wc, int fr, int fq) const {
#pragma unroll
        for (int g0i = 0; g0i < 16; g0i += 8) {
            u32x2 gw[8]; u32x4 tw[8];
#pragma unroll
            for (int k = 0; k < 8; ++k) { EPI_PIECE(g0i + k) gw[k] = *(const u32x2*)(G + row * ldc + u.pn * BM + cin); tw[k] = *(const u32x4*)(T + row * ldc + u.pn * BM + cin); }
            EPI_FENCE();
#pragma unroll
            for (int k = 0; k < 8; ++k) { EPI_PIECE(g0i + k)
                f32x4 g0, g1, t0, t1; unpack8g(gw[k], g0, g1); unpack8(tw[k], t0, t1);
                *(u32x4*)(O + row * ldc + u.pn * BM + cin) = pack8(t0 + g0 * acc[ai][bj][m][0], t1 + g1 * acc[ai][bj][m][1]); }
            EPI_FENCE();
        }
    }
};
struct EpiResF {
    static constexpr bool PERM = true, AFTER_DRAIN = false, CHAIN = false;
    const float* base; bf16_t* out; int ldc; float alpha;
    __device__ __forceinline__ void operator()(const f32x4 (&acc)[2][2][4][2], const Unit& u, int wr, int wc, int fr, int fq) const {
#pragma unroll
        for (int g0i = 0; g0i < 16; g0i += 8) {
            f32x4 t0[8], t1[8];
#pragma unroll
            for (int k = 0; k < 8; ++k) { EPI_PIECE(g0i + k) t0[k] = __builtin_nontemporal_load((const f32x4*)(base + row * ldc + u.pn * BM + cin)); t1[k] = __builtin_nontemporal_load((const f32x4*)(base + row * ldc + u.pn * BM + cin + 4)); }
            EPI_FENCE();
#pragma unroll
            for (int k = 0; k < 8; ++k) { EPI_PIECE(g0i + k)
                *(u32x4*)(out + row * ldc + u.pn * BM + cin) = pack8h(t0[k] * alpha + acc[ai][bj][m][0], t1[k] * alpha + acc[ai][bj][m][1]); }
            EPI_FENCE();
        }
    }
};
struct EpiResB {
    static constexpr bool PERM = true, AFTER_DRAIN = false, CHAIN = false;
    const bf16_t* base; bf16_t* out; int ldc; float alpha;
    __device__ __forceinline__ void operator()(const f32x4 (&acc)[2][2][4][2], const Unit& u, int wr, int wc, int fr, int fq) const {
        u32x4 bw[16];
#pragma unroll
        for (int c = 0; c < 16; ++c) { EPI_PIECE(c) bw[c] = *(const u32x4*)(base + row * ldc + u.pn * BM + cin); }
        EPI_FENCE();
#pragma unroll
        for (int c = 0; c < 16; ++c) { EPI_PIECE(c)
            f32x4 t0, t1; unpack8(bw[c], t0, t1);
            *(u32x4*)(out + row * ldc + u.pn * BM + cin) = pack8h(t0 * alpha + acc[ai][bj][m][0], t1 * alpha + acc[ai][bj][m][1]); }
    }
};
struct EpiFfn {
    static constexpr bool PERM = true, AFTER_DRAIN = false, CHAIN = false;
    bf16_t* O; int ldc;
    __device__ __forceinline__ void operator()(const f32x4 (&acc)[2][2][4][2], const Unit& u, int wr, int wc, int fr, int fq) const {
#pragma unroll
        for (int ai = 0; ai < 2; ++ai)
#pragma unroll
            for (int m = 0; m < 4; ++m) { const size_t row = (size_t)(u.pm * BM + ai * HALF + wr * 64 + m * 16 + fr);
                const f32x4 g0 = acc[ai][0][m][0], g1 = acc[ai][0][m][1], u0 = acc[ai][1][m][0], u1 = acc[ai][1][m][1];
                f32x4 v0, v1;
#pragma unroll
                for (int j = 0; j < 4; ++j) { v0[j] = g0[j] * sigm(g0[j]) * u0[j]; v1[j] = g1[j] * sigm(g1[j]) * u1[j]; }
                __builtin_nontemporal_store(pack8(v0, v1), (u32x4*)(O + row * ldc + u.pn * HALF + wc * 32 + 8 * fq)); }
    }
};
struct EpiMixChain {
    static constexpr bool PERM = true, AFTER_DRAIN = false, CHAIN = true;
    const unsigned char* GA; const unsigned char* GS; bf16_t* O; int ldc;
    __device__ __forceinline__ void operator()(f32x4 (&acc)[2][2][4][2], const Unit& u, int wr, int wc, int fr, int fq) const {
        if (u.gi == 0) {
#pragma unroll
            for (int g0i = 0; g0i < 16; g0i += 8) {
                u32x2 aw[8], sw[8];
#pragma unroll
                for (int k = 0; k < 8; ++k) { EPI_PIECE(g0i + k) aw[k] = *(const u32x2*)(GA + row * ldc + u.pn * BM + cin); sw[k] = *(const u32x2*)(GS + row * ldc + u.pn * BM + cin); }
                EPI_FENCE();
#pragma unroll
                for (int k = 0; k < 8; ++k) { EPI_PIECE(g0i + k)
#pragma unroll
                    for (int h = 0; h < 2; ++h) { const unsigned a = h ? aw[k].y : aw[k].x, sg = h ? sw[k].y : sw[k].x; f32x4 r;
#pragma unroll
                        for (int e = 0; e < 4; ++e) { const unsigned qa = (a >> (8 * e)) & 0xffu, qs = (sg >> (8 * e)) & 0xffu; r[e] = (float)qa * __builtin_amdgcn_rcpf((float)(qs > 1u ? qs : 1u)); }
                        acc[ai][bj][m][h] = acc[ai][bj][m][h] * r; } }
                EPI_FENCE();
            }
        } else {
            u32x2 sw[16];
#pragma unroll
            for (int c = 0; c < 16; ++c) { EPI_PIECE(c) sw[c] = *(const u32x2*)(GS + row * ldc + u.pn * BM + cin); }
            EPI_FENCE();
#pragma unroll
            for (int c = 0; c < 16; ++c) { EPI_PIECE(c)
                f32x4 g[2];
#pragma unroll
                for (int h = 0; h < 2; ++h) { const unsigned sg = h ? sw[c].y : sw[c].x;
#pragma unroll
                    for (int e = 0; e < 4; ++e) { const unsigned qs = (sg >> (8 * e)) & 0xffu; g[h][e] = (float)(qs > 1u ? qs : 1u) * (1.0f / 255.0f); } }
                *(u32x4*)(O + row * ldc + u.pn * BM + cin) = pack8(g[0] * acc[ai][bj][m][0], g[1] * acc[ai][bj][m][1]); }
        }
    }
};

template <class Epi, class Sched, bool ALIGN_EPI = false, bool SP2 = false>
__device__ __forceinline__ void gemm_phase(PG8_LAS unsigned char* lds, const Gemm g, const Sched& S, const Epi& E) {
    const int tid = threadIdx.x, wid = __builtin_amdgcn_readfirstlane(tid >> 6), lane = tid & 63, wr = wid >> 2, wc = wid & 3, fr = lane & 15, fq = lane >> 4;
    const int K = g.K, nt = K / BK;
    unsigned voffA[2], voffB[2];
#pragma unroll
    for (int i = 0; i < 2; ++i) { int R, C; stage_rc(tid * 16 + i * 8192, R, C); const int Rb = Epi::PERM ? ((R & ~31) + perm32(R & 31)) : R;
        voffA[i] = (unsigned)(R * K + C) * 2u; voffB[i] = (unsigned)(Rb * K + C) * 2u; }
    const size_t kstep = (size_t)(BK * 2);
    const size_t hstep = (size_t)HALF * K * 2;
    const size_t tstep = 2 * hstep;
    const unsigned ldsw = (unsigned)wid * 1024u;
    const int aoff = lds_byte(wr * 64 + fr, fq * 8), boff = lds_byte(wc * 32 + fr, fq * 8);
#define PG8_SA(b, h) (((b) * 2 + (h)) * HTB)
#define PG8_SB(b, h) ((4 + (b) * 2 + (h)) * HTB)
#define PG8_STAGE(bufoff, gbase, voff) do { _Pragma("unroll") for (int _i = 0; _i < 2; ++_i) \
        __builtin_amdgcn_global_load_lds((const unsigned*)((const char*)(gbase) + (voff)[_i]), (PG8_LAS unsigned*)(lds + (bufoff) + ldsw + _i * 8192), 16, 0, 0); } while (0)
#define PG8_LDA(dst, b, h) do { _Pragma("unroll") for (int m = 0; m < 4; ++m) _Pragma("unroll") for (int k = 0; k < 2; ++k) dst[m][k] = *(const PG8_LAS bf16x8*)(lds + PG8_SA(b, h) + aoff + m * 2048 + k * 1024); } while (0)
#define PG8_LDB(dst, b, h) do { _Pragma("unroll") for (int n = 0; n < 2; ++n) _Pragma("unroll") for (int k = 0; k < 2; ++k) dst[n][k] = *(const PG8_LAS bf16x8*)(lds + PG8_SB(b, h) + boff + n * 2048 + k * 1024); } while (0)
#define PG8_MMA(ai, bj, At, Bt) do { __builtin_amdgcn_s_setprio(1); _Pragma("unroll") for (int m = 0; m < 4; ++m) _Pragma("unroll") for (int n = 0; n < 2; ++n) _Pragma("unroll") for (int k = 0; k < 2; ++k) \
        acc[ai][bj][m][n] = __builtin_amdgcn_mfma_f32_16x16x32_bf16(Bt[n][k], At[m][k], acc[ai][bj][m][n], 0, 0, 0); __builtin_amdgcn_s_setprio(0); } while (0)
#define PG8_WAIT_V(n) asm volatile("s_waitcnt vmcnt(" #n ")" ::: "memory")
#define PG8_WAIT_L(n) asm volatile("s_waitcnt lgkmcnt(" #n ")" ::: "memory")
#define PG8_BAR __builtin_amdgcn_s_barrier()
#define PG8_SCHED __builtin_amdgcn_sched_barrier(0)
    Unit cur, nxt; int ui = 0;
    if (!S.next(0, cur)) return;
    f32x4 acc[2][2][4][2];
#pragma unroll
    for (int a = 0; a < 2; ++a)
#pragma unroll
        for (int b = 0; b < 2; ++b)
#pragma unroll
            for (int m = 0; m < 4; ++m)
#pragma unroll
                for (int n = 0; n < 2; ++n) acc[a][b][m][n] = (f32x4){0.f, 0.f, 0.f, 0.f};
    bf16x8 At[4][2], B0[2][2], B1[2][2];
    const char* cA = (const char*)(cur.gi ? g.A2 : g.A) + (size_t)cur.pm * tstep; const char* cB = (const char*)(cur.gi ? g.Bt2 : g.Bt) + (size_t)cur.pn * tstep;
    S.a_ready(cur);
    if constexpr (SP2) {
        PG8_STAGE(PG8_SB(0, 0), cB, voffB); PG8_STAGE(PG8_SB(0, 1), cB + hstep, voffB); PG8_STAGE(PG8_SA(0, 0), cA, voffA); PG8_STAGE(PG8_SA(0, 1), cA + hstep, voffA);
        if (wr == 1) PG8_BAR;
        PG8_WAIT_V(2); PG8_BAR;
        PG8_STAGE(PG8_SB(1, 0), cB + kstep, voffB); PG8_STAGE(PG8_SA(1, 0), cA + kstep, voffA); PG8_STAGE(PG8_SB(1, 1), cB + hstep + kstep, voffB);
        PG8_WAIT_V(6); PG8_BAR;
    } else {
        PG8_STAGE(PG8_SB(0, 0), cB, voffB); PG8_STAGE(PG8_SA(0, 0), cA, voffA); PG8_STAGE(PG8_SB(0, 1), cB + hstep, voffB); PG8_STAGE(PG8_SA(0, 1), cA + hstep, voffA);
        if (wr == 1) PG8_BAR;
        PG8_WAIT_V(4); PG8_BAR;
        PG8_STAGE(PG8_SB(1, 0), cB + kstep, voffB); PG8_STAGE(PG8_SA(1, 0), cA + kstep, voffA); PG8_STAGE(PG8_SB(1, 1), cB + hstep + kstep, voffB);
        PG8_WAIT_V(6); PG8_BAR;
    }
    for (;;) {
        const bool has_next = S.next(ui + 1, nxt);
        const char* nA = has_next ? (const char*)(nxt.gi ? g.A2 : g.A) + (size_t)nxt.pm * tstep : cA; const char* nB = has_next ? (const char*)(nxt.gi ? g.Bt2 : g.Bt) + (size_t)nxt.pn * tstep : cB;
        for (int t = 0; t < nt; t += 2) {
            const bool last = (t == nt - 2);
            const char* a1 = cA + (size_t)(t + 1) * kstep;
            const char* a2 = last ? nA : cA + (size_t)(t + 2) * kstep; const char* b2 = last ? nB : cB + (size_t)(t + 2) * kstep;
            const char* a3 = a2 + kstep; const char* b3 = b2 + kstep;
            if (last && has_next) S.a_ready(nxt);
            if constexpr (SP2) {
            PG8_LDB(B0, 0, 0); PG8_LDB(B1, 0, 1); PG8_SCHED; PG8_LDA(At, 0, 0); PG8_STAGE(PG8_SA(1, 1), a1 + hstep, voffA);
            PG8_WAIT_V(8); PG8_WAIT_L(0); PG8_BAR; PG8_MMA(0, 0, At, B0); PG8_MMA(0, 1, At, B1); PG8_BAR; PG8_SCHED;
            PG8_LDA(At, 0, 1); PG8_STAGE(PG8_SB(0, 0), b2, voffB); PG8_STAGE(PG8_SB(0, 1), b2 + hstep, voffB); PG8_STAGE(PG8_SA(0, 0), a2, voffA);
            PG8_WAIT_V(8); PG8_WAIT_L(0); PG8_BAR; PG8_MMA(1, 0, At, B0); PG8_MMA(1, 1, At, B1); PG8_BAR; PG8_SCHED;
            PG8_LDB(B0, 1, 0); PG8_LDB(B1, 1, 1); PG8_SCHED; PG8_LDA(At, 1, 0); PG8_STAGE(PG8_SA(0, 1), a2 + hstep, voffA);
            PG8_WAIT_V(8); PG8_WAIT_L(0); PG8_BAR; PG8_MMA(0, 0, At, B0); PG8_MMA(0, 1, At, B1); PG8_BAR; PG8_SCHED;
            PG8_LDA(At, 1, 1); PG8_STAGE(PG8_SB(1, 0), b3, voffB); PG8_STAGE(PG8_SB(1, 1), b3 + hstep, voffB); PG8_STAGE(PG8_SA(1, 0), a3, voffA);
            PG8_WAIT_V(8); PG8_WAIT_L(0); PG8_BAR; PG8_MMA(1, 0, At, B0); PG8_MMA(1, 1, At, B1); PG8_BAR; PG8_SCHED;
            } else {
            PG8_LDB(B0, 0, 0); PG8_SCHED; PG8_LDA(At, 0, 0); PG8_STAGE(PG8_SA(1, 1), a1 + hstep, voffA);
            PG8_WAIT_L(8); PG8_BAR; PG8_WAIT_L(0); PG8_MMA(0, 0, At, B0); PG8_BAR; PG8_SCHED;
            PG8_LDB(B1, 0, 1); PG8_STAGE(PG8_SB(0, 0), b2, voffB);
            PG8_BAR; PG8_WAIT_L(0); PG8_MMA(0, 1, At, B1); PG8_BAR;
            PG8_LDA(At, 0, 1); PG8_STAGE(PG8_SA(0, 0), a2, voffA);
            PG8_BAR; PG8_WAIT_L(0); PG8_MMA(1, 0, At, B0); PG8_BAR; PG8_SCHED;
            PG8_STAGE(PG8_SB(0, 1), b2 + hstep, voffB);
            PG8_WAIT_V(6); PG8_BAR; PG8_MMA(1, 1, At, B1); PG8_BAR;
            PG8_LDB(B0, 1, 0); PG8_SCHED; PG8_LDA(At, 1, 0); PG8_STAGE(PG8_SA(0, 1), a2 + hstep, voffA);
            PG8_WAIT_L(8); PG8_BAR; PG8_WAIT_L(0); PG8_MMA(0, 0, At, B0); PG8_BAR; PG8_SCHED;
            PG8_LDB(B1, 1, 1); PG8_STAGE(PG8_SB(1, 0), b3, voffB);
            PG8_BAR; PG8_WAIT_L(0); PG8_MMA(0, 1, At, B1); PG8_BAR;
            PG8_LDA(At, 1, 1); PG8_STAGE(PG8_SA(1, 0), a3, voffA);
            PG8_BAR; PG8_WAIT_L(0); PG8_MMA(1, 0, At, B0); PG8_BAR; PG8_SCHED;
            PG8_STAGE(PG8_SB(1, 1), b3 + hstep, voffB);
            PG8_WAIT_V(6); PG8_BAR; PG8_MMA(1, 1, At, B1); PG8_BAR;
            }
        }
        if constexpr (ALIGN_EPI) { if (wr == 0) PG8_BAR; }
        if constexpr (!Epi::AFTER_DRAIN) { E(acc, cur, wr, wc, fr, fq); S.done(cur); }
        if (!has_next) break;
        if (!(Epi::CHAIN && cur.gi == 0)) {
#pragma unroll
        for (int a = 0; a < 2; ++a)
#pragma unroll
            for (int b = 0; b < 2; ++b)
#pragma unroll
                for (int m = 0; m < 4; ++m)
#pragma unroll
                    for (int n = 0; n < 2; ++n) acc[a][b][m][n] = (f32x4){0.f, 0.f, 0.f, 0.f};
        }
        cur = nxt; cA = nA; cB = nB; ++ui;
        if constexpr (ALIGN_EPI) { if (wr == 1) PG8_BAR; }
    }
    PG8_WAIT_V(0);
    if constexpr (!ALIGN_EPI) { if (wr == 0) PG8_BAR; }
    PG8_BAR;
    if constexpr (Epi::AFTER_DRAIN) { E.fused(acc, cur, wr, wc, fr, fq, lds, wid, lane); S.done(cur); }
#undef PG8_SA
#undef PG8_SB
#undef PG8_STAGE
#undef PG8_LDA
#undef PG8_LDB
#undef PG8_MMA
#undef PG8_WAIT_V
#undef PG8_WAIT_L
#undef PG8_BAR
#undef PG8_SCHED
}
}

#define GAS __attribute__((address_space(1)))
#define LAS __attribute__((address_space(3)))
typedef unsigned short bf16;
typedef unsigned v4u __attribute__((ext_vector_type(4)));
typedef unsigned v2u __attribute__((ext_vector_type(2)));
typedef float f32x4 __attribute__((ext_vector_type(4)));
typedef float f32x16 __attribute__((ext_vector_type(16)));
typedef short bf16x8 __attribute__((ext_vector_type(8)));
using pg8::cvt_pk_bf16; using pg8::bf_lo; using pg8::bf_hi; using pg8::sigm;

constexpr int NWAVES = 8, NTHR = 512;
constexpr int M = 16384, D = 2048, NAW = 1024, S5W = 1024, DFF = 5632;
constexpr int NPROJ = 7168;
constexpr int GW = 64, NROWS = 256, NH = 8, HD = 128;
constexpr int SL = 256, NS = M / SL, NBLK = SL / 16;
constexpr float LN_EPS = 1e-5f;
constexpr float ALPHA = 1.189207115002721f;
constexpr float LOG2E = 1.4426950408889634f;
constexpr float QSCALE = 0.08838834764831845f * LOG2E;

constexpr size_t MiB = 1u << 20;
constexpr size_t WS_CTL = 0, CTL_ZERO_BYTES = 16384;
constexpr size_t WS_LAMB = 1 * MiB;
constexpr size_t WS_BMAT = 1 * MiB + 65536;
constexpr size_t WS_CMAT = 2 * MiB;
constexpr size_t WS_EST = 3 * MiB;
constexpr size_t WS_WIN = 8 * MiB, WS_WV = 36 * MiB, WS_WNA = 40 * MiB, WS_WGLU = 44 * MiB, WS_WS5O = 46 * MiB, WS_WOUT = 50 * MiB, WS_WGU = 58 * MiB, WS_WDN = 102 * MiB;
constexpr size_t WS_GA = 124 * MiB, WS_GS = 188 * MiB, WS_PRE1 = 124 * MiB, WS_PRE2 = 124 * MiB, WS_HH = 188 * MiB;
constexpr size_t WS_XB = 252 * MiB, WS_ATT = 252 * MiB, WS_YS2 = 284 * MiB, WS_HB = 252 * MiB;
constexpr size_t WS_Q = 316 * MiB, WS_U = 348 * MiB, WS_K = 380 * MiB, WS_VT = 412 * MiB;
constexpr size_t WS_YS = 380 * MiB, WS_GATED = 316 * MiB, WS_ACT = 316 * MiB, WS_END = 492 * MiB;
constexpr int LDS_BYTES = 147456;

#define LDS_WAIT() asm volatile("s_waitcnt lgkmcnt(0)" ::: "memory")
#define VM_WAIT() asm volatile("s_waitcnt vmcnt(0)" ::: "memory")
__device__ __forceinline__ float wave_sum(float v) {
#pragma unroll
    for (int o = 1; o < 64; o <<= 1) v += __shfl_xor(v, o);
    return v;
}
__device__ __forceinline__ float gelu_tanh(float x) { const float z = 0.7978845608028654f * (x + 0.044715f * x * x * x); return x * sigm(2.0f * z); }

__device__ __forceinline__ void p0_transpose_item(const float* W, int K, int N, bf16* WT, int out_row0, int kb, int nb, LAS float* scr, int lane) {
    const int k0 = 64 * kb, n0 = 32 * nb;
    float tmp[32];
    const float* wp = W + (size_t)(k0 + (lane >> 5)) * N + n0 + (lane & 31);
#pragma unroll
    for (int i = 0; i < 32; ++i) tmp[i] = __builtin_nontemporal_load(wp + (size_t)(2 * i) * N);
#pragma unroll
    for (int i = 0; i < 32; ++i) scr[(2 * i + (lane >> 5)) * 33 + (lane & 31)] = tmp[i];
    LDS_WAIT(); asm volatile("" ::: "memory");
    const int c = lane & 7;
#pragma unroll
    for (int j = 0; j < 4; ++j) { const int n = (lane >> 3) + 8 * j; const LAS float* s = scr + (8 * c) * 33 + n;
        v4u o; o.x = cvt_pk_bf16(s[0 * 33], s[1 * 33]); o.y = cvt_pk_bf16(s[2 * 33], s[3 * 33]); o.z = cvt_pk_bf16(s[4 * 33], s[5 * 33]); o.w = cvt_pk_bf16(s[6 * 33], s[7 * 33]);
        *(v4u*)(WT + (size_t)(out_row0 + n) * K + k0 + 8 * c) = o; }
    LDS_WAIT(); asm volatile("" ::: "memory");
}
__device__ __forceinline__ double dexp_small(double x) {
    const double y = x * (1.0 / 128.0); double t = 1.0 / 479001600.0;
    t = t * y + 1.0 / 39916800.0; t = t * y + 1.0 / 3628800.0; t = t * y + 1.0 / 362880.0; t = t * y + 1.0 / 40320.0; t = t * y + 1.0 / 5040.0; t = t * y + 1.0 / 720.0;
    t = t * y + 1.0 / 120.0; t = t * y + 1.0 / 24.0; t = t * y + 1.0 / 6.0; t = t * y + 0.5; t = t * y + 1.0; t = t * y + 1.0;
#pragma unroll
    for (int i = 0; i < 7; ++i) t = t * t;
    return t;
}
__device__ __forceinline__ void dsincos_small(double th, double& sn, double& cs) {
    const double kf = __builtin_rint(th * 0.6366197723675814); const int k = (int)kf;
    double r = th - kf * 1.5707963267948966; r = r - kf * 6.123233995736766e-17;
    const double r2 = r * r;
    double s = -1.0 / 355687428096000.0;
    s = s * r2 + 1.0 / 1307674368000.0; s = s * r2 - 1.0 / 6227020800.0; s = s * r2 + 1.0 / 39916800.0; s = s * r2 - 1.0 / 362880.0; s = s * r2 + 1.0 / 5040.0; s = s * r2 - 1.0 / 120.0; s = s * r2 + 1.0 / 6.0;
    s = r - r * r2 * s;
    double c = 1.0 / 20922789888000.0;
    c = c * r2 - 1.0 / 87178291200.0; c = c * r2 + 1.0 / 479001600.0; c = c * r2 - 1.0 / 3628800.0; c = c * r2 + 1.0 / 40320.0; c = c * r2 - 1.0 / 720.0; c = c * r2 + 1.0 / 24.0; c = c * r2 - 0.5; c = c * r2 + 1.0;
    const int q = k & 3;
    sn = (q == 0) ? s : (q == 1) ? c : (q == 2) ? -s : -c;
    cs = (q == 0) ? c : (q == 1) ? -s : (q == 2) ? -c : s;
}

#define XB_TMO      128
#define XB_XCNT(j)  (256  + 64 * (j))
#define XB_XSUB(j)  (1280 + 64 * (j))
#define XB_XGEN(j)  (2304 + 64 * (j))
#define XB_TOP      3328
#define XB_TOPGEN   3392
#define XCD_BAR_WORDS 3456
#define XB_SPIN_CAP (1u << 18)

__device__ __forceinline__ unsigned xb_ld(unsigned* p)              { return __hip_atomic_load(p, __ATOMIC_RELAXED, __HIP_MEMORY_SCOPE_AGENT); }
__device__ __forceinline__ unsigned xb_add(unsigned* p, unsigned v) { return __hip_atomic_fetch_add(p, v, __ATOMIC_RELAXED, __HIP_MEMORY_SCOPE_AGENT); }
__device__ __forceinline__ unsigned xb_xcc_id() { return (unsigned)__builtin_amdgcn_s_getreg((3 << 11) | 20) & 0xFu; }
#define XB_SPIN(cond, bar) do { unsigned _sp = 0; while (cond) { __builtin_amdgcn_s_sleep(1); \
    if ((++_sp & 255u) == 0u) { if (xb_ld(&(bar)[XB_TMO])) break; if (_sp > XB_SPIN_CAP) { atomicAdd(&(bar)[XB_TMO], 1u); break; } } } } while (0)

struct XcdBarrier {
    unsigned* bar; unsigned x;
    volatile LAS unsigned* st;
};

__device__ __forceinline__ XcdBarrier xcd_barrier_post(unsigned* bar, volatile LAS unsigned* st) {
    XcdBarrier b; b.bar = bar; b.x = xb_xcc_id(); b.st = st;
    if (threadIdx.x == 0) (void)xb_add(&bar[XB_XCNT(b.x)], 1u);
    return b;
}
__device__ __forceinline__ void xcd_barrier_complete(unsigned* bar, unsigned x, unsigned& nloc, unsigned& nx) {
    const unsigned G = gridDim.x * gridDim.y * gridDim.z;
    unsigned sum, cnt, mine, sp = 0u;
    for (;;) {
        sum = 0u; cnt = 0u; mine = 0u;
#pragma unroll
        for (unsigned j = 0; j < 16; ++j) { const unsigned c = xb_ld(&bar[XB_XCNT(j)]); sum += c; cnt += (c > 0u) ? 1u : 0u; mine = (j == x) ? c : mine; }
        if (sum == G) break;
        __builtin_amdgcn_s_sleep(1);
        if ((++sp & 255u) == 0u) { if (xb_ld(&bar[XB_TMO])) break; if (sp > XB_SPIN_CAP) { atomicAdd(&bar[XB_TMO], 1u); break; } }
    }
    nloc = mine > 0u ? mine : 1u; nx = cnt > 0u ? cnt : 1u;
}

__device__ __forceinline__ void xcd_barrier(const XcdBarrier& b) {
    asm volatile("s_waitcnt vmcnt(0)" ::: "memory");
    __syncthreads();
    if (threadIdx.x == 0) {
        unsigned* bar = b.bar;
        __builtin_amdgcn_s_waitcnt(0);
        unsigned nloc = b.st[0], nx = b.st[1];
        if (nloc == 0u) { xcd_barrier_complete(bar, b.x, nloc, nx); b.st[0] = nloc; b.st[1] = nx; }
        const unsigned old = xb_add(&bar[XB_XSUB(b.x)], 1u);
        const unsigned gen = old / nloc;
        if (old + 1u == (gen + 1u) * nloc) {
            __builtin_amdgcn_fence(__ATOMIC_RELEASE, "agent");
            asm volatile("s_waitcnt vmcnt(0)" ::: "memory");
            const unsigned og = xb_add(&bar[XB_TOP], 1u);
            const unsigned tg = og / nx;
            if (og + 1u == (tg + 1u) * nx) xb_add(&bar[XB_TOPGEN], 1u);
            else XB_SPIN(xb_ld(&bar[XB_TOPGEN]) == tg, bar);
            __builtin_amdgcn_fence(__ATOMIC_ACQUIRE, "agent");
            xb_add(&bar[XB_XGEN(b.x)], 1u);
            asm volatile("s_waitcnt vmcnt(0)" ::: "memory");
        } else {
            XB_SPIN(xb_ld(&bar[XB_XGEN(b.x)]) == gen, bar);
            __builtin_amdgcn_fence(__ATOMIC_ACQUIRE, "agent");
            asm volatile("s_waitcnt vmcnt(0)" ::: "memory");
        }
    }
    __syncthreads();
}

struct Args { const float* in[24]; float* out; unsigned char* ws; int ph_lo, ph_hi; };

#define MFMA32(a, b, c) __builtin_amdgcn_mfma_f32_32x32x16_bf16((a), (b), (c), 0, 0, 0)
#define MFMA16(a, b, c) __builtin_amdgcn_mfma_f32_16x16x32_bf16((a), (b), (c), 0, 0, 0)

template <bool FINAL>
__device__ __forceinline__ void s5_run(const unsigned char* ws, const bf16* U, int sp, int g, int dir, LAS unsigned char* wl, int lane,
                                       float* YF, bf16* YS, const float* s5d) {
    const int n = lane & 31, hi = lane >> 5;
    const int dg = dir * 64 + g;
    const float* LAMB = (const float*)(ws + WS_LAMB);
    const bf16* BMAT = (const bf16*)(ws + WS_BMAT);
    const bf16* CMAT = (const bf16*)(ws + WS_CMAT);
    f32x4* EST = (f32x4*)(ws + WS_EST);
    const float lr0 = LAMB[(dg * 64 + n) * 2], li0 = LAMB[(dg * 64 + n) * 2 + 1], lr1 = LAMB[(dg * 64 + 32 + n) * 2], li1 = LAMB[(dg * 64 + 32 + n) * 2 + 1];
    bf16x8 Bf[4];
#pragma unroll
    for (int T = 0; T < 4; ++T) Bf[T] = *(const bf16x8*)(BMAT + ((size_t)(dg * 128 + 32 * T + n)) * 16 + hi * 8);
    const int sseg = FINAL ? (dir ? NS - 1 - (2 * sp + hi) : 2 * sp + hi) : 2 * sp + hi;
    float sr0 = 0.f, si0 = 0.f, sr1 = 0.f, si1 = 0.f;
    if (FINAL) {
        float ar0 = lr0, ai0 = li0, ar1 = lr1, ai1 = li1;
#pragma unroll
        for (int i = 0; i < 8; ++i) { const float t0 = ar0 * ar0 - ai0 * ai0, u0 = 2.f * ar0 * ai0, t1 = ar1 * ar1 - ai1 * ai1, u1 = 2.f * ar1 * ai1; ar0 = t0; ai0 = u0; ar1 = t1; ai1 = u1; }
        const int smax = dir ? NS - 1 - 2 * sp : 2 * sp + 1;
        const f32x4* E = EST + (size_t)dg * NS * 32 + n;
        for (int s0 = 0; s0 < smax; s0 += 16) {
            f32x4 e[16];
#pragma unroll
            for (int j = 0; j < 16; ++j) { const int idx = (s0 + j) < NS ? (s0 + j) : NS - 1; e[j] = E[(size_t)idx * 32]; }
#pragma unroll
            for (int j = 0; j < 16; ++j) if (s0 + j < sseg) {
                const float nr0 = ar0 * sr0 - ai0 * si0 + e[j][0], ni0 = ar0 * si0 + ai0 * sr0 + e[j][1];
                const float nr1 = ar1 * sr1 - ai1 * si1 + e[j][2], ni1 = ar1 * si1 + ai1 * sr1 + e[j][3];
                sr0 = nr0; si0 = ni0; sr1 = nr1; si1 = ni1; }
        }
    }
    bf16x8 Cf[4];
    if (FINAL) {
#pragma unroll
        for (int ks = 0; ks < 4; ++ks) Cf[ks] = *(const bf16x8*)(CMAT + ((size_t)(dg * 16 + (lane & 15))) * 128 + 32 * ks + (lane >> 4) * 8);
    }
    const int m = lane & 31, hm = (m >> 2) & 1, im = 4 * (m >> 3) + (m & 3);
    const int segm = FINAL ? (dir ? NS - 1 - (2 * sp + hm) : 2 * sp + hm) : 2 * sp + hm;
    const f32x16 zero16 = {0.f, 0.f, 0.f, 0.f, 0.f, 0.f, 0.f, 0.f, 0.f, 0.f, 0.f, 0.f, 0.f, 0.f, 0.f, 0.f};
    float dsk[4] = {0.f, 0.f, 0.f, 0.f};
    if (FINAL && dir == 1) {
#pragma unroll
        for (int j = 0; j < 4; ++j) dsk[j] = s5d[g * 16 + 4 * (lane >> 4) + j];
    }
    const int tau0 = segm * SL + im;
    const bf16* up0 = U + (size_t)(dir ? (M - 1 - tau0) : tau0) * S5W + g * 16 + hi * 8;
    const long ustep = dir ? -16L * S5W : 16L * S5W;
    bf16x8 ufr[2];
#pragma unroll
    for (int u = 0; u < 2; ++u) ufr[u] = *(const bf16x8*)(up0 + (long)u * ustep);
    const int nn = lane & 15, q4 = lane >> 4;
    const size_t obase = (size_t)(2 * sp * SL + nn) * S5W + g * 16 + 4 * q4;
    v2u yfr[2][2]; v2u uwr[2][2];
    if (FINAL && dir == 1) {
#pragma unroll
        for (int b = 0; b < 2; ++b)
#pragma unroll
            for (int mt = 0; mt < 2; ++mt) { const size_t off = obase + (size_t)(mt * SL + 16 * (NBLK - 1 - b)) * S5W; yfr[b][mt] = *(const v2u*)((const bf16*)YF + off); uwr[b][mt] = *(const v2u*)(U + off); }
    }
    for (int b4 = 0; b4 < NBLK; b4 += 2)
#pragma unroll
    for (int u = 0; u < 2; ++u) {
        const int b = b4 + u;
        const bf16x8 uf = ufr[u];
        if (b + 2 < NBLK) ufr[u] = *(const bf16x8*)(up0 + (long)(b + 2) * ustep);
        f32x16 a0 = MFMA32(uf, Bf[0], zero16), a1 = MFMA32(uf, Bf[1], zero16), a2 = MFMA32(uf, Bf[2], zero16), a3 = MFMA32(uf, Bf[3], zero16);
#pragma unroll
        for (int i = 0; i < 16; ++i) {
            const float nr0 = lr0 * sr0 - li0 * si0 + a0[i], ni0 = lr0 * si0 + li0 * sr0 + a2[i];
            const float nr1 = lr1 * sr1 - li1 * si1 + a1[i], ni1 = lr1 * si1 + li1 * sr1 + a3[i];
            sr0 = nr0; si0 = ni0; sr1 = nr1; si1 = ni1;
            if (FINAL) { LAS unsigned* rowp = (LAS unsigned*)(wl + (hi * 16 + i) * 272);
                rowp[n] = cvt_pk_bf16(sr0, si0); rowp[32 + n] = cvt_pk_bf16(sr1, si1); }
        }
        if (FINAL) {
#pragma unroll
            for (int mt = 0; mt < 2; ++mt) {
                f32x4 y = {0.f, 0.f, 0.f, 0.f};
                const int srow = mt * 16 + (dir ? 15 - nn : nn);
#pragma unroll
                for (int ks = 0; ks < 4; ++ks) { const bf16x8 sf = *(const LAS bf16x8*)(wl + srow * 272 + (32 * ks + q4 * 8) * 2); y = MFMA16(Cf[ks], sf, y); }
                const int bb = dir ? (NBLK - 1 - b) : b;
                const size_t off = obase + (size_t)(mt * SL + 16 * bb) * S5W;
                if (dir == 0) { v2u yw; yw.x = cvt_pk_bf16(y[0], y[1]); yw.y = cvt_pk_bf16(y[2], y[3]); *(v2u*)((bf16*)YF + off) = yw; }
                else {
                    const v2u yq = yfr[u & 1][mt]; const f32x4 yf = {bf_lo(yq.x), bf_hi(yq.x), bf_lo(yq.y), bf_hi(yq.y)};
                    const v2u uw = uwr[u & 1][mt];
                    float o[4];
                    o[0] = yf[0] + y[0] + dsk[0] * bf_lo(uw.x); o[1] = yf[1] + y[1] + dsk[1] * bf_hi(uw.x);
                    o[2] = yf[2] + y[2] + dsk[2] * bf_lo(uw.y); o[3] = yf[3] + y[3] + dsk[3] * bf_hi(uw.y);
#pragma unroll
                    for (int j = 0; j < 4; ++j) o[j] = gelu_tanh(o[j]);
                    v2u w; w.x = cvt_pk_bf16(o[0], o[1]); w.y = cvt_pk_bf16(o[2], o[3]);
                    *(v2u*)(YS + off) = w;
                    if (b + 2 < NBLK) { const size_t off2 = obase + (size_t)(mt * SL + 16 * (NBLK - 1 - (b + 2))) * S5W; yfr[u & 1][mt] = *(const v2u*)((const bf16*)YF + off2); uwr[u & 1][mt] = *(const v2u*)(U + off2); }
                }
            }
        }
        __builtin_amdgcn_sched_barrier(0);
    }
    if (!FINAL) EST[((size_t)dg * NS + sseg) * 32 + n] = (f32x4){sr0, si0, sr1, si1};
}

__device__ __forceinline__ void s5_pass1_pair(const unsigned char* ws, const bf16* U, int spA, int spB, int g, int dir, int lane) {
    const int n = lane & 31, hi = lane >> 5;
    const int dg = dir * 64 + g;
    const float* LAMB = (const float*)(ws + WS_LAMB);
    const bf16* BMAT = (const bf16*)(ws + WS_BMAT);
    f32x4* EST = (f32x4*)(ws + WS_EST);
    const int m = lane & 31, hm = (m >> 2) & 1, im = 4 * (m >> 3) + (m & 3);
    const int tauA = (2 * spA + hm) * SL + im, tauB = (2 * spB + hm) * SL + im;
    const bf16* upA = U + (size_t)(dir ? (M - 1 - tauA) : tauA) * S5W + g * 16 + hi * 8;
    const bf16* upB = U + (size_t)(dir ? (M - 1 - tauB) : tauB) * S5W + g * 16 + hi * 8;
    const long ustep = dir ? -16L * S5W : 16L * S5W;
    bf16x8 ufA[2], ufB[2];
#pragma unroll
    for (int u = 0; u < 2; ++u) { ufA[u] = *(const bf16x8*)(upA + (long)u * ustep); ufB[u] = *(const bf16x8*)(upB + (long)u * ustep); }
    const float lr0 = LAMB[(dg * 64 + n) * 2], li0 = LAMB[(dg * 64 + n) * 2 + 1], lr1 = LAMB[(dg * 64 + 32 + n) * 2], li1 = LAMB[(dg * 64 + 32 + n) * 2 + 1];
    bf16x8 Bf[4];
#pragma unroll
    for (int T = 0; T < 4; ++T) Bf[T] = *(const bf16x8*)(BMAT + ((size_t)(dg * 128 + 32 * T + n)) * 16 + hi * 8);
    const f32x16 zero16 = {0.f, 0.f, 0.f, 0.f, 0.f, 0.f, 0.f, 0.f, 0.f, 0.f, 0.f, 0.f, 0.f, 0.f, 0.f, 0.f};
    float ar0 = 0.f, ai0 = 0.f, ar1 = 0.f, ai1 = 0.f, br0 = 0.f, bi0 = 0.f, br1 = 0.f, bi1 = 0.f;
    for (int b2 = 0; b2 < NBLK; b2 += 2)
#pragma unroll
    for (int u = 0; u < 2; ++u) {
        const int b = b2 + u;
        const bf16x8 fa = ufA[u], fb = ufB[u];
        if (b + 2 < NBLK) { ufA[u] = *(const bf16x8*)(upA + (long)(b + 2) * ustep); ufB[u] = *(const bf16x8*)(upB + (long)(b + 2) * ustep); }
        f32x16 a0 = MFMA32(fa, Bf[0], zero16), a1 = MFMA32(fa, Bf[1], zero16), a2 = MFMA32(fa, Bf[2], zero16), a3 = MFMA32(fa, Bf[3], zero16);
        f32x16 c0 = MFMA32(fb, Bf[0], zero16), c1 = MFMA32(fb, Bf[1], zero16), c2 = MFMA32(fb, Bf[2], zero16), c3 = MFMA32(fb, Bf[3], zero16);
#pragma unroll
        for (int i = 0; i < 16; ++i) {
            const float nr0 = lr0 * ar0 - li0 * ai0 + a0[i], ni0 = lr0 * ai0 + li0 * ar0 + a2[i];
            const float nr1 = lr1 * ar1 - li1 * ai1 + a1[i], ni1 = lr1 * ai1 + li1 * ar1 + a3[i];
            const float mr0 = lr0 * br0 - li0 * bi0 + c0[i], mi0 = lr0 * bi0 + li0 * br0 + c2[i];
            const float mr1 = lr1 * br1 - li1 * bi1 + c1[i], mi1 = lr1 * bi1 + li1 * br1 + c3[i];
            ar0 = nr0; ai0 = ni0; ar1 = nr1; ai1 = ni1; br0 = mr0; bi0 = mi0; br1 = mr1; bi1 = mi1;
        }
        __builtin_amdgcn_sched_barrier(0);
    }
    EST[((size_t)dg * NS + 2 * spA + hi) * 32 + n] = (f32x4){ar0, ai0, ar1, ai1};
    EST[((size_t)dg * NS + 2 * spB + hi) * 32 + n] = (f32x4){br0, bi0, br1, bi1};
}

constexpr int AT_KSTR = 272, AT_VSTR = 144, AT_KBUF = 64 * AT_KSTR, AT_VBUF = 128 * AT_VSTR, AT_STAGE = AT_KBUF + AT_VBUF;
__device__ __forceinline__ void attn_step(const LAS unsigned char* kp, const LAS unsigned char* vp0, const LAS float* rpr, const bf16x8 (&Qf)[4], const int (&bofs)[8], f32x4 (&O)[8], float& mrun, float& lsum) {
    float bias[8];
#pragma unroll
    for (int s = 0; s < 8; ++s) bias[s] = rpr[bofs[s]];
    f32x4 S[2];
#pragma unroll
    for (int nt = 0; nt < 2; ++nt) { f32x4 s = {0.f, 0.f, 0.f, 0.f};
#pragma unroll
        for (int ks = 0; ks < 4; ++ks) { const bf16x8 kf = *(const LAS bf16x8*)(kp + 16 * nt * AT_KSTR + ks * 64); s = MFMA16(kf, Qf[ks], s); }
        S[nt] = s; }
    float v[8]; float ml = -1e30f;
#pragma unroll
    for (int s = 0; s < 8; ++s) { v[s] = S[s >> 2][s & 3] + bias[s]; ml = fmaxf(ml, v[s]); }
    ml = fmaxf(ml, __shfl_xor(ml, 16)); ml = fmaxf(ml, __shfl_xor(ml, 32));
    const float mnew = fmaxf(mrun, ml), al = __builtin_amdgcn_exp2f(mrun - mnew); mrun = mnew;
    float ps = 0.f;
#pragma unroll
    for (int s = 0; s < 8; ++s) { v[s] = __builtin_amdgcn_exp2f(v[s] - mnew); ps += v[s]; }
    lsum = lsum * al + ps;
    v4u pw; pw.x = cvt_pk_bf16(v[0], v[1]); pw.y = cvt_pk_bf16(v[2], v[3]); pw.z = cvt_pk_bf16(v[4], v[5]); pw.w = cvt_pk_bf16(v[6], v[7]);
    const bf16x8 pf = __builtin_bit_cast(bf16x8, pw);
#pragma unroll
    for (int dt = 0; dt < 8; ++dt) {
        const LAS unsigned char* vp = vp0 + 16 * dt * AT_VSTR;
        const v2u lo = *(const LAS v2u*)vp, hi2 = *(const LAS v2u*)(vp + 32);
        v4u vw; vw.x = lo.x; vw.y = lo.y; vw.z = hi2.x; vw.w = hi2.y;
        O[dt] = MFMA16(__builtin_bit_cast(bf16x8, vw), pf, O[dt] * al);
    }
}
__device__ __forceinline__ void attn_block(const bf16* Q, const bf16* K, const bf16* VT, bf16* ATT, const float* rpb, int rp4, int h, LAS unsigned char* lds, int wave, int lane, int tid) {
    const int n = lane & 15, q4 = lane >> 4, rw = wave >> 2, j = wave & 3;
    const int rA = 4 * rp4 + rw, rB = rA + 2;
    const int r0A = rA < 4 ? 0 : (rA > NROWS - 4 ? NROWS - 8 : rA - 4), r0B = rB < 4 ? 0 : (rB > NROWS - 4 ? NROWS - 8 : rB - 4);
    const int ra = 4 * rp4, rb = 4 * rp4 + 3;
    const int kmin = ra < 4 ? 0 : (ra > NROWS - 4 ? NROWS - 8 : ra - 4);
    const int kmax = (rb < 4 ? 0 : (rb > NROWS - 4 ? NROWS - 8 : rb - 4)) + 7;
    const int nkr = kmax - kmin + 1;
    const int kc0 = (j == 0) ? 0 : (j == 1) ? 8 : (j == 2) ? 24 : 32;
    const int c = 16 * j + n;
    const int cs = c < 8 ? 0 : (c > 56 ? 48 : c - 8);
    const size_t tqA = (size_t)rA * GW + c, tqB = (size_t)rB * GW + c;
    const bf16* kg[2]; const bf16* vg[2]; int kl[2], vl[2];
#pragma unroll
    for (int i = 0; i < 2; ++i) { const int p = tid + 512 * i;
        kg[i] = K + (size_t)(p >> 4) * NAW + h * HD + (p & 15) * 8 + (size_t)kmin * GW * NAW; kl[i] = (p >> 4) * AT_KSTR + (p & 15) * 16;
        vg[i] = VT + (size_t)(h * HD + (p >> 3)) * M + (p & 7) * 8 + (size_t)kmin * GW; vl[i] = AT_KBUF + (p >> 3) * AT_VSTR + (p & 7) * 16; }
    v4u kA[2], vA[2], kB[2], vB[2];
#define AT_LOAD(KR, VR, st) do { _Pragma("unroll") for (int i = 0; i < 2; ++i) { KR[i] = *(const v4u*)(kg[i] + (size_t)(st) * GW * NAW); VR[i] = *(const v4u*)(vg[i] + (size_t)(st) * GW); } } while (0)
#define AT_WRITE(KR, VR, buf) do { LAS unsigned char* nb_ = lds + (buf) * AT_STAGE; _Pragma("unroll") for (int i = 0; i < 2; ++i) { *(LAS v4u*)(nb_ + kl[i]) = KR[i]; *(LAS v4u*)(nb_ + vl[i]) = VR[i]; } } while (0)
    AT_LOAD(kA, vA, 0);
    AT_LOAD(kB, vB, 1);
    bf16x8 QfA[4], QfB[4];
#pragma unroll
    for (int ks = 0; ks < 4; ++ks) { QfA[ks] = *(const bf16x8*)(Q + tqA * NAW + h * HD + 32 * ks + q4 * 8); QfB[ks] = *(const bf16x8*)(Q + tqB * NAW + h * HD + 32 * ks + q4 * 8); }
    int bofs[8];
#pragma unroll
    for (int s = 0; s < 8; ++s) { const int kc = kc0 + 16 * (s >> 2) + 4 * q4 + (s & 3); const bool val = (kc >= cs) && (kc < cs + 16); int bi = kc - c + 15; bi = bi < 0 ? 0 : (bi > 30 ? 30 : bi); bofs[s] = val ? bi : 31; asm volatile("" : "+v"(bofs[s])); }
    const LAS unsigned char* kp0 = lds + (kc0 + n) * AT_KSTR + q4 * 16; const LAS unsigned char* vp0 = lds + AT_KBUF + n * AT_VSTR + (kc0 + 4 * q4) * 2;
    asm volatile("" : "+v"(kp0), "+v"(vp0));
    f32x4 OA[8], OB[8];
#pragma unroll
    for (int dt = 0; dt < 8; ++dt) { OA[dt] = (f32x4){0.f, 0.f, 0.f, 0.f}; OB[dt] = (f32x4){0.f, 0.f, 0.f, 0.f}; }
    float mA = -1e30f, lA = 0.f, mB = -1e30f, lB = 0.f;
    LAS float* rpb_h = (LAS float*)(lds + 2 * AT_STAGE);
    if (tid < 15 * 32) rpb_h[tid] = (tid & 31) < 31 ? rpb[(size_t)h * 15 * 31 + (tid >> 5) * 31 + (tid & 31)] * LOG2E : -1e30f;
    AT_WRITE(kA, vA, 0);
    __syncthreads();
    const int nst = (nkr + 1) & ~1, lastst = nkr - 1;
    for (int it = 0; it < nst; it += 2) {
        { const int st = it + 2 < lastst ? it + 2 : lastst; AT_LOAD(kA, vA, st); }
        { const int kr = kmin + it;
          if (kr >= r0A && kr <= r0A + 7) attn_step(kp0, vp0, rpb_h + (kr - rA + 7) * 32, QfA, bofs, OA, mA, lA);
          if (kr >= r0B && kr <= r0B + 7) attn_step(kp0, vp0, rpb_h + (kr - rB + 7) * 32, QfB, bofs, OB, mB, lB); }
        AT_WRITE(kB, vB, 1);
        __syncthreads();
        { const int st = it + 3 < lastst ? it + 3 : lastst; AT_LOAD(kB, vB, st); }
        { const int kr = kmin + it + 1;
          if (kr >= r0A && kr <= r0A + 7 && it + 1 < nkr) attn_step(kp0 + AT_STAGE, vp0 + AT_STAGE, rpb_h + (kr - rA + 7) * 32, QfA, bofs, OA, mA, lA);
          if (kr >= r0B && kr <= r0B + 7 && it + 1 < nkr) attn_step(kp0 + AT_STAGE, vp0 + AT_STAGE, rpb_h + (kr - rB + 7) * 32, QfB, bofs, OB, mB, lB); }
        AT_WRITE(kA, vA, 0);
        __syncthreads();
    }
#undef AT_LOAD
#undef AT_WRITE
    lA += __shfl_xor(lA, 16); lA += __shfl_xor(lA, 32); lB += __shfl_xor(lB, 16); lB += __shfl_xor(lB, 32);
    const float invA = 1.0f / lA, invB = 1.0f / lB;
#pragma unroll
    for (int dt = 0; dt < 8; ++dt) {
        v2u w; w.x = cvt_pk_bf16(OA[dt][0] * invA, OA[dt][1] * invA); w.y = cvt_pk_bf16(OA[dt][2] * invA, OA[dt][3] * invA);
        *(v2u*)(ATT + tqA * NAW + h * HD + 16 * dt + 4 * q4) = w;
        v2u x; x.x = cvt_pk_bf16(OB[dt][0] * invB, OB[dt][1] * invB); x.y = cvt_pk_bf16(OB[dt][2] * invB, OB[dt][3] * invB);
        *(v2u*)(ATT + tqB * NAW + h * HD + 16 * dt + 4 * q4) = x;
    }
}

__device__ __forceinline__ void ln_row_compute(const v4u (&w)[4], float* orow, bf16* brow, bf16* hrow, const f32x4 (&gg)[8], const f32x4 (&bb)[8], int lane) {
    f32x4 v[8]; float s = 0.f;
#pragma unroll
    for (int jj = 0; jj < 4; ++jj) pg8::unpack8h(w[jj], v[2 * jj], v[2 * jj + 1]);
#pragma unroll
    for (int jj = 0; jj < 8; ++jj) s += (v[jj][0] + v[jj][1]) + (v[jj][2] + v[jj][3]);
    const float mean = wave_sum(s) * (1.f / D); float s2 = 0.f;
#pragma unroll
    for (int jj = 0; jj < 8; ++jj) { v[jj] = v[jj] - mean; s2 += (v[jj][0] * v[jj][0] + v[jj][1] * v[jj][1]) + (v[jj][2] * v[jj][2] + v[jj][3] * v[jj][3]); }
    const float rstd = 1.f / sqrtf(wave_sum(s2) * (1.f / D) + LN_EPS);
#pragma unroll
    for (int jj = 0; jj < 4; ++jj) {
        const int e4 = 2 * (64 * jj + lane);
        const f32x4 o0 = v[2 * jj] * rstd * gg[2 * jj] + bb[2 * jj], o1 = v[2 * jj + 1] * rstd * gg[2 * jj + 1] + bb[2 * jj + 1];
        if (orow) { ((f32x4*)orow)[e4] = o0; ((f32x4*)orow)[e4 + 1] = o1; }
        if (brow) { ((v4u*)brow)[64 * jj + lane] = pg8::pack8(o0, o1); }
        if (hrow) { ((v4u*)hrow)[64 * jj + lane] = pg8::pack8h(o0, o1); }
    }
}
__device__ __forceinline__ void ln_phase(const bf16* X, float* OF, bf16* OB, bf16* OH, const float* gam, const float* bet, int gw, int NGW, int lane) {
    f32x4 gg[8], bb[8];
#pragma unroll
    for (int jj = 0; jj < 4; ++jj) { const int e4 = 2 * (64 * jj + lane); gg[2 * jj] = ((const f32x4*)gam)[e4]; gg[2 * jj + 1] = ((const f32x4*)gam)[e4 + 1]; bb[2 * jj] = ((const f32x4*)bet)[e4]; bb[2 * jj + 1] = ((const f32x4*)bet)[e4 + 1]; }
    for (int base = gw; base < M; base += 4 * NGW) {
        v4u w[4][4];
#pragma unroll
        for (int k = 0; k < 4; ++k) { const int row = base + k * NGW < M ? base + k * NGW : M - 1;
#pragma unroll
            for (int jj = 0; jj < 4; ++jj) w[k][jj] = __builtin_nontemporal_load((const v4u*)(X + (size_t)row * D) + 64 * jj + lane); }
#pragma unroll
        for (int k = 0; k < 4; ++k) { const int row = base + k * NGW;
            if (row < M) ln_row_compute(w[k], OF ? OF + (size_t)row * D : nullptr, OB ? OB + (size_t)row * D : nullptr, OH ? OH + (size_t)row * D : nullptr, gg, bb, lane); }
    }
}

constexpr int TI_IN = 32 * 256, TI_NA = 16 * 64, TI_GLU = 16 * 32, TI_S5O = 16 * 64, TI_OUT = 32 * 64, TI_FG = 32 * 176, TI_FD = 88 * 64;
constexpr int TI_ALL = TI_IN + TI_NA + TI_GLU + TI_S5O + TI_OUT + 2 * TI_FG + TI_FD;
__device__ __forceinline__ void transpose_item_any(const Args& args, unsigned char* ws, int it, LAS float* scr, int lane) {
    bf16* WinT = (bf16*)(ws + WS_WIN); bf16* WvT = (bf16*)(ws + WS_WV); bf16* WnaT = (bf16*)(ws + WS_WNA); bf16* WgluT = (bf16*)(ws + WS_WGLU);
    bf16* Ws5oT = (bf16*)(ws + WS_WS5O); bf16* WoutT = (bf16*)(ws + WS_WOUT); bf16* WguT = (bf16*)(ws + WS_WGU); bf16* WdnT = (bf16*)(ws + WS_WDN);
    int rr = it;
    if (rr < TI_IN) { const int kb = rr / 256, nb = rr % 256, n0 = 32 * nb;
        if (n0 >= 2048 && n0 < 3072) p0_transpose_item(args.in[1], D, 8192, WvT, n0 - 2048, kb, nb, scr, lane);
        else { const int orow = n0 < 2048 ? n0 : (n0 < 4096 ? 2048 + (n0 - 3072) : 3072 + (n0 - 4096)); p0_transpose_item(args.in[1], D, 8192, WinT, orow, kb, nb, scr, lane); }
        return; } rr -= TI_IN;
    if (rr < TI_NA) { p0_transpose_item(args.in[4], NAW, D, WnaT, 32 * (rr % 64), rr / 64, rr % 64, scr, lane); return; } rr -= TI_NA;
    if (rr < TI_GLU) { p0_transpose_item(args.in[13], S5W, S5W, WgluT, 32 * (rr % 32), rr / 32, rr % 32, scr, lane); return; } rr -= TI_GLU;
    if (rr < TI_S5O) { p0_transpose_item(args.in[15], S5W, D, Ws5oT, 32 * (rr % 64), rr / 64, rr % 64, scr, lane); return; } rr -= TI_S5O;
    if (rr < TI_OUT) { p0_transpose_item(args.in[16], D, D, WoutT, 32 * (rr % 64), rr / 64, rr % 64, scr, lane); return; } rr -= TI_OUT;
    if (rr < TI_FG) { const int nb = rr % 176, f0 = 32 * nb; p0_transpose_item(args.in[19], D, DFF, WguT, (f0 / 128) * 256 + (f0 % 128), rr / 176, nb, scr, lane); return; } rr -= TI_FG;
    if (rr < TI_FG) { const int nb = rr % 176, f0 = 32 * nb; p0_transpose_item(args.in[20], D, DFF, WguT, (f0 / 128) * 256 + 128 + (f0 % 128), rr / 176, nb, scr, lane); return; } rr -= TI_FG;
    p0_transpose_item(args.in[21], DFF, D, WdnT, 32 * (rr % 64), rr / 64, rr % 64, scr, lane);
}

__global__ void __launch_bounds__(NTHR, 2) mk_fwd(Args args) {
    extern __shared__ __attribute__((aligned(16))) unsigned char lds_raw[];
    LAS unsigned char* lds = (LAS unsigned char*)lds_raw;
    cg::grid_group grid = cg::this_grid();
    const int tid = threadIdx.x, lane = tid & 63, wave = __builtin_amdgcn_readfirstlane(tid >> 6);
    const int G = gridDim.x, bx = blockIdx.x;
    const int vcu = (G % 8 == 0) ? (bx % 8) * (G / 8) + bx / 8 : bx;
    const int gw = vcu * NWAVES + wave, NGW = G * NWAVES;
    unsigned char* ws = args.ws;
    const int lo = args.ph_lo, hi = args.ph_hi;
    volatile LAS unsigned* MISC = (volatile LAS unsigned*)(lds + LDS_BYTES - 128);
    if (tid < 32) MISC[tid] = 0u;
    __syncthreads();
    const XcdBarrier xbar = xcd_barrier_post((unsigned*)(ws + WS_CTL), MISC + 8);
    if (lo < 0) grid.sync();
#define IN(k) (lo <= (k) && (k) < hi)
#define SEAM(k) do { if (IN(k) && IN((k) + 1)) xcd_barrier(xbar); } while (0)
    const float* x = args.in[0];
    bf16* WinT = (bf16*)(ws + WS_WIN); bf16* WvT = (bf16*)(ws + WS_WV); bf16* WnaT = (bf16*)(ws + WS_WNA); bf16* WgluT = (bf16*)(ws + WS_WGLU);
    bf16* Ws5oT = (bf16*)(ws + WS_WS5O); bf16* WoutT = (bf16*)(ws + WS_WOUT); bf16* WguT = (bf16*)(ws + WS_WGU); bf16* WdnT = (bf16*)(ws + WS_WDN);
    bf16* XB = (bf16*)(ws + WS_XB); bf16* Qb = (bf16*)(ws + WS_Q); bf16* Kb = (bf16*)(ws + WS_K); bf16* VTb = (bf16*)(ws + WS_VT); bf16* Ub = (bf16*)(ws + WS_U);
    unsigned char* GAb = ws + WS_GA; unsigned char* GSb = ws + WS_GS; bf16* ATT = (bf16*)(ws + WS_ATT); bf16* YS = (bf16*)(ws + WS_YS); bf16* YS2 = (bf16*)(ws + WS_YS2);
    bf16* GATED = (bf16*)(ws + WS_GATED); bf16* PRE1 = (bf16*)(ws + WS_PRE1); bf16* PRE2 = (bf16*)(ws + WS_PRE2); bf16* HH = (bf16*)(ws + WS_HH); bf16* HB = (bf16*)(ws + WS_HB); bf16* ACT = (bf16*)(ws + WS_ACT);

    if (IN(0)) {
        LAS float* scr = (LAS float*)(lds + wave * 16384);
        for (int it = gw; it < TI_IN; it += NGW) transpose_item_any(args, ws, it, scr, lane);
        const int gt = vcu * NTHR + tid, NT = G * NTHR;
        for (int i8 = gt; i8 < M * D / 8; i8 += 4 * NT) {
            f32x4 a[4], b[4];
#pragma unroll
            for (int u = 0; u < 4; ++u) { const size_t j8 = (size_t)i8 + (size_t)u * NT < (size_t)M * D / 8 ? (size_t)i8 + (size_t)u * NT : (size_t)i8; a[u] = __builtin_nontemporal_load((const f32x4*)x + 2 * j8); b[u] = __builtin_nontemporal_load((const f32x4*)x + 2 * j8 + 1); }
#pragma unroll
            for (int u = 0; u < 4; ++u) { v4u o; o.x = cvt_pk_bf16(a[u][0], a[u][1]); o.y = cvt_pk_bf16(a[u][2], a[u][3]); o.z = cvt_pk_bf16(b[u][0], b[u][1]); o.w = cvt_pk_bf16(b[u][2], b[u][3]);
                if ((size_t)i8 + (size_t)u * NT < (size_t)M * D / 8) ((v4u*)XB)[i8 + u * NT] = o; }
        }
        float* LAMB = (float*)(ws + WS_LAMB); bf16* BMAT = (bf16*)(ws + WS_BMAT); unsigned* CMAT = (unsigned*)(ws + WS_CMAT);
        for (int idx = gt; idx < 2 * 64 * 64; idx += NT) {
            const int dgi = idx >> 6, p = idx & 63;
            const double are = (double)args.in[5][idx], aim = (double)args.in[6][idx];
            const double dt = dexp_small((double)args.in[7][dgi]);
            const double er = dexp_small(are * dt); double sn, cs; dsincos_small(aim * dt, sn, cs);
            const double lbr = er * cs, lbi = er * sn;
            LAMB[idx * 2] = (float)lbr; LAMB[idx * 2 + 1] = (float)lbi;
            const double nr = lbr - 1.0, ni = lbi, den = are * are + aim * aim;
            const double cr = (nr * are + ni * aim) / den, ci = (ni * are - nr * aim) / den;
            const float* bre = args.in[8] + (size_t)idx * 16; const float* bim = args.in[9] + (size_t)idx * 16;
#pragma unroll
            for (int c2 = 0; c2 < 16; c2 += 2) {
                const double br0 = bre[c2], bi0 = bim[c2], br1 = bre[c2 + 1], bi1 = bim[c2 + 1];
                *(unsigned*)(BMAT + ((size_t)dgi * 128 + p) * 16 + c2) = cvt_pk_bf16((float)(cr * br0 - ci * bi0), (float)(cr * br1 - ci * bi1));
                *(unsigned*)(BMAT + ((size_t)dgi * 128 + 64 + p) * 16 + c2) = cvt_pk_bf16((float)(cr * bi0 + ci * br0), (float)(cr * bi1 + ci * br1));
            }
        }
        for (int idx = gt; idx < 2 * 64 * 16 * 64; idx += NT) CMAT[idx] = cvt_pk_bf16(args.in[10][idx], -args.in[11][idx]);
    }
    SEAM(0);

    if (IN(1)) {
        { pg8::Gemm g{XB, WinT, M, NPROJ, D}; pg8::StaticOrder S; S.init(M, NPROJ, G, bx, 4);
          pg8::EpiProj E{Qb, Kb, Ub, GAb, GSb, args.in[2], QSCALE};
          pg8::gemm_phase<pg8::EpiProj, pg8::StaticOrder, true, true>(lds, g, S, E); }
        { pg8::Gemm g{WvT, XB, NAW, M, D}; pg8::StaticOrder S; S.init(NAW, M, G, bx);
          pg8::EpiPlain E{VTb, M};
          pg8::gemm_phase<pg8::EpiPlain, pg8::StaticOrder, true, true>(lds, g, S, E); }
    }
    SEAM(1);

    if (IN(2)) {
        if (NGW == 2048) {
            const int dir = gw & 1, g = (gw >> 1) & 63, sp = gw >> 7;
            s5_pass1_pair(ws, Ub, sp, sp + 16, g, dir, lane);
        } else
        for (int it = gw; it < (NS / 2) * 64 * 2; it += NGW) { const int dir = it & 1, g = (it >> 1) & 63, sp = it >> 7;
            s5_run<false>(ws, Ub, sp, g, dir, lds, lane, nullptr, nullptr, nullptr); }
        __syncthreads();
        for (int it = vcu; it < (NROWS / 4) * NH; it += G) attn_block(Qb, Kb, VTb, ATT, args.in[3], it >> 3, it & 7, lds, wave, lane, tid);
    }
    SEAM(2);

    if (IN(3)) {
        LAS unsigned char* wl = lds + wave * 8704;
        LAS float* scr3 = (LAS float*)(lds + 73728 + wave * 8448);
        if (wave >= 4) { for (int it = TI_IN + gw; it < TI_ALL; it += NGW) transpose_item_any(args, ws, it, scr3, lane); }
        for (int it = gw; it < (NS / 2) * 64; it += NGW) { const int g = it & 63, sp = it >> 6;
            s5_run<true>(ws, Ub, sp, g, 0, wl, lane, args.out, YS, args.in[12]);
            s5_run<true>(ws, Ub, sp, g, 1, wl, lane, args.out, YS, args.in[12]); }
        if (wave < 4) { for (int it = TI_IN + gw; it < TI_ALL; it += NGW) transpose_item_any(args, ws, it, scr3, lane); }
        __syncthreads();
    }
    SEAM(3);

    if (IN(4)) {
        pg8::Gemm g{YS, WgluT, M, S5W, S5W}; pg8::StaticOrder S; S.init(M, S5W, G, bx);
        pg8::EpiGlu E{YS, YS2, S5W, args.in[14]};
        pg8::gemm_phase<pg8::EpiGlu, pg8::StaticOrder, true, true>(lds, g, S, E);
    }
    SEAM(4);

    if (IN(5)) {
        pg8::Gemm g{ATT, WnaT, M, D, NAW, YS2, Ws5oT}; pg8::PairOrder S; S.s.init(M, D, G, bx, 4);
        pg8::EpiMixChain E{GAb, GSb, GATED, D};
        pg8::gemm_phase<pg8::EpiMixChain, pg8::PairOrder, true, true>(lds, g, S, E);
    }
    SEAM(5);

    if (IN(6)) {
        pg8::Gemm g{GATED, WoutT, M, D, D}; pg8::StaticOrder S; S.init(M, D, G, bx, 4);
        pg8::EpiResF E{x, PRE1, D, ALPHA};
        pg8::gemm_phase<pg8::EpiResF, pg8::StaticOrder, true, true>(lds, g, S, E);
    }
    SEAM(6);

    if (IN(7)) ln_phase(PRE1, nullptr, HB, nullptr, args.in[17], args.in[18], gw, NGW, lane);
    SEAM(7);

    if (IN(8)) {
        pg8::Gemm g{HB, WguT, M, 2 * DFF, D}; pg8::StaticOrder S; S.init(M, 2 * DFF, G, bx, 4, 1);
        pg8::EpiFfn E{ACT, DFF};
        pg8::gemm_phase<pg8::EpiFfn, pg8::StaticOrder, true, true>(lds, g, S, E);
    }
    SEAM(8);

    if (IN(9)) {
        pg8::Gemm g{ACT, WdnT, M, D, DFF}; pg8::StaticOrder S; S.init(M, D, G, bx, 4);
        pg8::EpiResB E{HB, PRE2, D, ALPHA};
        pg8::gemm_phase<pg8::EpiResB, pg8::StaticOrder, true, true>(lds, g, S, E);
    }
    SEAM(9);

    if (IN(10)) ln_phase(PRE2, args.out, nullptr, nullptr, args.in[22], args.in[23], gw, NGW, lane);
#undef IN
#undef SEAM
}

#ifndef MK_DUP
#define MK_DUP 0
#endif
#ifndef MK_N_LAUNCHES
#define MK_N_LAUNCHES 1
#endif
constexpr int NPHASES = 11;

extern "C" void kernel_launch(void* const* d_in, const int* in_sizes, int n_in, void* d_out, int out_size, void* d_ws, size_t ws_size, hipStream_t stream) {
    static int grid = 0;
    if (grid == 0) {
        if (n_in != 24 || in_sizes[0] != M * D || out_size != M * D || ws_size < WS_END) { fprintf(stderr, "kernel_launch: unexpected shapes (n_in %d, in0 %d, out %d, ws %zu)\n", n_in, n_in > 0 ? in_sizes[0] : -1, out_size, ws_size); grid = -1; return; }
        int dev = 0, cus = 0, per_cu = 0;
        if (hipGetDevice(&dev) != hipSuccess || hipDeviceGetAttribute(&cus, hipDeviceAttributeMultiprocessorCount, dev) != hipSuccess) { grid = -1; return; }
        if (hipFuncSetAttribute((const void*)mk_fwd, hipFuncAttributeMaxDynamicSharedMemorySize, LDS_BYTES) != hipSuccess) { fprintf(stderr, "kernel_launch: hipFuncSetAttribute failed\n"); grid = -1; return; }
        if (hipOccupancyMaxActiveBlocksPerMultiprocessor(&per_cu, (const void*)mk_fwd, NTHR, LDS_BYTES) != hipSuccess || per_cu < 1) { fprintf(stderr, "kernel_launch: occupancy query says %d\n", per_cu); per_cu = 1; }
        (void)hipGetLastError();
        grid = cus;
    }
    if (grid < 0) return;
    if (hipMemsetAsync((char*)d_ws + WS_CTL, 0, CTL_ZERO_BYTES, stream) != hipSuccess) { fprintf(stderr, "kernel_launch: memset of the barrier words failed\n"); return; }
    Args a{};
    for (int i = 0; i < 24; ++i) a.in[i] = (const float*)d_in[i];
    a.out = (float*)d_out; a.ws = (unsigned char*)d_ws;
    if (MK_N_LAUNCHES == 1) {
        a.ph_lo = 0; a.ph_hi = NPHASES;
        void* kargs[] = {&a};
        hipError_t e = hipLaunchCooperativeKernel((const void*)mk_fwd, dim3(grid), dim3(NTHR), kargs, LDS_BYTES, stream);
        if (e != hipSuccess) fprintf(stderr, "kernel_launch: cooperative launch failed: %s (grid %d)\n", hipGetErrorString(e), grid);
    } else {
        for (int p = 0; p < NPHASES; ++p) { a.ph_lo = p; a.ph_hi = p + 1;
            const int reps = ((MK_DUP >> p) & 1) ? 2 : 1;
            for (int q = 0; q < reps; ++q) hipLaunchKernelGGL(mk_fwd, dim3(grid), dim3(NTHR), LDS_BYTES, stream, a); }
    }
}
```

```cpp
#include <hip/hip_runtime.h>
#include <hip/hip_cooperative_groups.h>
#include <cstdio>
#include <cstdint>
namespace cg = cooperative_groups;
namespace pg8 {
#define PG8_LAS __attribute__((address_space(3)))
typedef unsigned short bf16_t;
typedef short bf16x8 __attribute__((ext_vector_type(8)));
typedef float f32x4 __attribute__((ext_vector_type(4)));
typedef unsigned u32x4 __attribute__((ext_vector_type(4)));
constexpr int BM = 256, BK = 64, HALF = 128, HTB = HALF * BK * 2  , STAGE_BYTES = 8 * HTB, NXCD = 8, WGM = 8;

__host__ __device__ __forceinline__ int lds_byte(int r, int c) { const int st = (r >> 4) * 2 + (c >> 5), rr = r & 15, cc = c & 31, ob = rr * 64 + cc * 2; return st * 1024 + (ob ^ (((ob >> 9) & 1) << 5)); }
__host__ __device__ __forceinline__ void stage_rc(int b, int& R, int& C) { const int st = b / 1024, sb = b % 1024, swz = sb ^ (((sb >> 9) & 1) << 5); R = (st >> 1) * 16 + swz / 64; C = (st & 1) * 32 + (swz % 64) / 2; }
__host__ __device__ __forceinline__ int perm32(int rho) { const int n = rho >> 4, i = rho & 15; return 8 * (i >> 2) + 4 * n + (i & 3); }

struct Unit { int pm, pn, gi; };
struct Gemm { const bf16_t* A; const bf16_t* Bt; int M, N, K; const bf16_t* A2 = nullptr; const bf16_t* Bt2 = nullptr; };

struct StaticOrder {
    int nM, nN, nwg, G, c, wgm, swp;
    __host__ __device__ void init(int M, int N, int G_, int c_, int wgm_ = WGM, int swp_ = 0) { nM = M / BM; nN = N / BM; nwg = nM * nN; G = G_; c = c_; wgm = wgm_; swp = swp_; }
    __host__ __device__ bool next(int i, Unit& u) const { const long L = (long)i * G + c; if (L >= nwg) return false; at(L, u); return true; }
    __host__ __device__ void at(long L, Unit& u) const {
        u.gi = 0;
        int wgid = (int)L; { const int q = nwg / NXCD, r = nwg % NXCD, xcd = wgid % NXCD, off = wgid / NXCD; wgid = (xcd < r ? xcd * (q + 1) : r * (q + 1) + (xcd - r) * q) + off; }
        const int rM = swp ? nN : nM, rN = swp ? nM : nN;
        const int nig = wgm * rN, gid = wgid / nig, fm = gid * wgm, gsz = (rM - fm) < wgm ? (rM - fm) : wgm;
        const int ta = fm + ((wgid % nig) % gsz), tb = (wgid % nig) / gsz;
        u.pm = swp ? tb : ta; u.pn = swp ? ta : tb;
    }
    __device__ __forceinline__ void a_ready(const Unit&) const {}
    __device__ __forceinline__ void done(const Unit&) const {}
};


typedef __bf16 bf16x2_t __attribute__((ext_vector_type(2)));
typedef float f32x2_t __attribute__((ext_vector_type(2)));
__device__ __forceinline__ unsigned cvt_pk_bf16(float lo, float hi) { f32x2_t f = {lo, hi}; bf16x2_t b = __builtin_convertvector(f, bf16x2_t); return __builtin_bit_cast(unsigned, b); }
__device__ __forceinline__ float bf_lo(unsigned w) { return __uint_as_float(w << 16); }
__device__ __forceinline__ float bf_hi(unsigned w) { return __uint_as_float(w & 0xffff0000u); }
__device__ __forceinline__ float sigm(float v) { return __builtin_amdgcn_rcpf(1.0f + __builtin_amdgcn_exp2f(v * -1.44269504089f)); }
__device__ __forceinline__ u32x4 pack8(const f32x4 v0, const f32x4 v1) { u32x4 w; w.x = cvt_pk_bf16(v0[0], v0[1]); w.y = cvt_pk_bf16(v0[2], v0[3]); w.z = cvt_pk_bf16(v1[0], v1[1]); w.w = cvt_pk_bf16(v1[2], v1[3]); return w; }
__device__ __forceinline__ void unpack8(const u32x4 w, f32x4& v0, f32x4& v1) { v0 = (f32x4){bf_lo(w.x), bf_hi(w.x), bf_lo(w.y), bf_hi(w.y)}; v1 = (f32x4){bf_lo(w.z), bf_hi(w.z), bf_lo(w.w), bf_hi(w.w)}; }

__device__ __forceinline__ unsigned cvt_pk_q16(float lo, float hi) { return __builtin_bit_cast(unsigned, __builtin_amdgcn_cvt_pknorm_i16(lo * 0.03125f, hi * 0.03125f)); }
__device__ __forceinline__ u32x4 pack8h(const f32x4 v0, const f32x4 v1) { u32x4 w; w.x = cvt_pk_q16(v0[0], v0[1]); w.y = cvt_pk_q16(v0[2], v0[3]); w.z = cvt_pk_q16(v1[0], v1[1]); w.w = cvt_pk_q16(v1[2], v1[3]); return w; }
__device__ __forceinline__ float q_lo(unsigned w) { return (float)(short)(w & 0xffffu) * (32.0f / 32767.0f); }
__device__ __forceinline__ float q_hi(unsigned w) { return (float)((int)w >> 16) * (32.0f / 32767.0f); }
__device__ __forceinline__ void unpack8h(const u32x4 w, f32x4& v0, f32x4& v1) { v0 = (f32x4){q_lo(w.x), q_hi(w.x), q_lo(w.y), q_hi(w.y)}; v1 = (f32x4){q_lo(w.z), q_hi(w.z), q_lo(w.w), q_hi(w.w)}; }

struct PairOrder {
    StaticOrder s;
    __host__ __device__ bool next(int i, Unit& u) const { const long L = (long)(i >> 1) * s.G + s.c; if (L >= s.nwg) return false; s.at(L, u); u.gi = i & 1; return true; }
    __device__ __forceinline__ void a_ready(const Unit&) const {}
    __device__ __forceinline__ void done(const Unit&) const {}
};
typedef unsigned u32x2 __attribute__((ext_vector_type(2)));
__device__ __forceinline__ unsigned q8(float v) { return (unsigned)(v * 255.0f + 0.5f); }
__device__ __forceinline__ u32x2 pack8g(const f32x4 v0, const f32x4 v1) { u32x2 w; w.x = q8(v0[0]) | (q8(v0[1]) << 8) | (q8(v0[2]) << 16) | (q8(v0[3]) << 24); w.y = q8(v1[0]) | (q8(v1[1]) << 8) | (q8(v1[2]) << 16) | (q8(v1[3]) << 24); return w; }
__device__ __forceinline__ void unpack8g(const u32x2 w, f32x4& v0, f32x4& v1) { const float k = 1.0f / 255.0f;
    v0 = (f32x4){(float)(w.x & 0xffu) * k, (float)((w.x >> 8) & 0xffu) * k, (float)((w.x >> 16) & 0xffu) * k, (float)(w.x >> 24) * k};
    v1 = (f32x4){(float)(w.y & 0xffu) * k, (float)((w.y >> 8) & 0xffu) * k, (float)((w.y >> 16) & 0xffu) * k, (float)(w.y >> 24) * k}; }

#define EPI_PIECE(c) const int ai = (c) >> 3, m = ((c) >> 1) & 3, bj = (c) & 1; const size_t row = (size_t)(u.pm * BM + ai * HALF + wr * 64 + m * 16 + fr); const int cin = bj * HALF + wc * 32 + 8 * fq; (void)row; (void)cin;
#define EPI_FENCE() asm volatile("" ::: "memory")

struct EpiPlain {
    static constexpr bool PERM = true, AFTER_DRAIN = false, CHAIN = false;
    bf16_t* O; int ldc;
    __device__ __forceinline__ void operator()(const f32x4 (&acc)[2][2][4][2], const Unit& u, int wr, int wc, int fr, int fq) const {
#pragma unroll
        for (int c = 0; c < 16; ++c) { EPI_PIECE(c) *(u32x4*)(O + row * ldc + u.pn * BM + cin) = pack8(acc[ai][bj][m][0], acc[ai][bj][m][1]); }
    }
};
struct EpiProj {
    static constexpr bool PERM = true, AFTER_DRAIN = false, CHAIN = false;
    bf16_t *Q, *K, *U; unsigned char *GA, *GS; const float* bgate; float qscale;
    __device__ __forceinline__ void operator()(const f32x4 (&acc)[2][2][4][2], const Unit& u, int wr, int wc, int fr, int fq) const {
        const int pn = u.pn; bf16_t* base = Q; unsigned char* gbase = GA; int ldc, colt; float sc = 1.0f; bool gate = false;
        if (pn < 4) { base = Q; ldc = 1024; colt = pn * BM; sc = qscale; }
        else if (pn < 8) { base = K; ldc = 1024; colt = (pn - 4) * BM; }
        else if (pn < 12) { base = U; ldc = 1024; colt = (pn - 8) * BM; }
        else if (pn < 20) { gbase = GA; ldc = 2048; colt = (pn - 12) * BM; gate = true; }
        else { gbase = GS; ldc = 2048; colt = (pn - 20) * BM; gate = true; }
        const float* bp = bgate + (pn >= 12 ? (pn - 12) * BM : 0) + wc * 32 + 8 * fq;
        f32x4 bv[2][2];
#pragma unroll
        for (int bj = 0; bj < 2; ++bj) { bv[bj][0] = gate ? *(const f32x4*)(bp + bj * HALF) : (f32x4){0.f, 0.f, 0.f, 0.f}; bv[bj][1] = gate ? *(const f32x4*)(bp + bj * HALF + 4) : (f32x4){0.f, 0.f, 0.f, 0.f}; }
        EPI_FENCE();
#pragma unroll
        for (int c = 0; c < 16; ++c) { EPI_PIECE(c)
            f32x4 v0 = acc[ai][bj][m][0], v1 = acc[ai][bj][m][1];
            if (gate) { v0 = v0 + bv[bj][0]; v1 = v1 + bv[bj][1];
                v0 = (f32x4){sigm(v0[0]), sigm(v0[1]), sigm(v0[2]), sigm(v0[3])}; v1 = (f32x4){sigm(v1[0]), sigm(v1[1]), sigm(v1[2]), sigm(v1[3])};
                __builtin_nontemporal_store(pack8g(v0, v1), (u32x2*)(gbase + row * ldc + colt + cin)); }
            else { v0 = v0 * sc; v1 = v1 * sc; *(u32x4*)(base + row * ldc + colt + cin) = pack8(v0, v1); } }
    }
};
struct EpiGlu {
    static constexpr bool PERM = true, AFTER_DRAIN = false, CHAIN = false;
    const bf16_t* Y; bf16_t* O; int ldc; const float* bias;
    __device__ __forceinline__ void operator()(const f32x4 (&acc)[2][2][4][2], const Unit& u, int wr, int wc, int fr, int fq) const {
        f32x4 bv[2][2]; u32x4 yw[16];
#pragma unroll
        for (int bj = 0; bj < 2; ++bj) { const float* bp = bias + u.pn * BM + bj * HALF + wc * 32 + 8 * fq; bv[bj][0] = *(const f32x4*)bp; bv[bj][1] = *(const f32x4*)(bp + 4); }
#pragma unroll
        for (int c = 0; c < 16; ++c) { EPI_PIECE(c) yw[c] = *(const u32x4*)(Y + row * ldc + u.pn * BM + cin); }
        EPI_FENCE();
#pragma unroll
        for (int c = 0; c < 16; ++c) { EPI_PIECE(c)
            f32x4 y0, y1; unpack8(yw[c], y0, y1);
            f32x4 v0 = acc[ai][bj][m][0] + bv[bj][0], v1 = acc[ai][bj][m][1] + bv[bj][1];
            v0 = (f32x4){y0[0] * sigm(v0[0]), y0[1] * sigm(v0[1]), y0[2] * sigm(v0[2]), y0[3] * sigm(v0[3])};
            v1 = (f32x4){y1[0] * sigm(v1[0]), y1[1] * sigm(v1[1]), y1[2] * sigm(v1[2]), y1[3] * sigm(v1[3])};
            *(u32x4*)(O + row * ldc + u.pn * BM + cin) = pack8(v0, v1); }
    }
};
struct EpiMixA {
    static constexpr bool PERM = true, AFTER_DRAIN = false, CHAIN = false;
    const unsigned char* G; bf16_t* T; int ldc;
    __device__ __forceinline__ void operator()(const f32x4 (&acc)[2][2][4][2], const Unit& u, int wr, int wc, int fr, int fq) const {
        u32x2 gw[16];
#pragma unroll
        for (int c = 0; c < 16; ++c) { EPI_PIECE(c) gw[c] = *(const u32x2*)(G + row * ldc + u.pn * BM + cin); }
        EPI_FENCE();
#pragma unroll
        for (int c = 0; c < 16; ++c) { EPI_PIECE(c)
            f32x4 g0, g1; unpack8g(gw[c], g0, g1);
            *(u32x4*)(T + row * ldc + u.pn * BM + cin) = pack8(g0 * acc[ai][bj][m][0], g1 * acc[ai][bj][m][1]); }
    }
};
struct EpiMixB {
    static constexpr bool PERM = true, AFTER_DRAIN = false, CHAIN = false;
    const unsigned char* G; const bf16_t* T; bf16_t* O; int ldc;
    __device__ __forceinline__ void operator()(const f32x4 (&acc)[2][2][4][2], const Unit& u, int wr, int wc, int fr, int fq) const {
#pragma unroll
        for (int g0i = 0; g0i < 16; g0i += 8) {
            u32x2 gw[8]; u32x4 tw[8];
#pragma unroll
            for (int k = 0; k < 8; ++k) { EPI_PIECE(g0i + k) gw[k] = *(const u32x2*)(G + row * ldc + u.pn * BM + cin); tw[k] = *(const u32x4*)(T + row * ldc + u.pn * BM + cin); }
            EPI_FENCE();
#pragma unroll
            for (int k = 0; k < 8; ++k) { EPI_PIECE(g0i + k)
                f32x4 g0, g1, t0, t1; unpack8g(gw[k], g0, g1); unpack8(tw[k], t0, t1);
                *(u32x4*)(O + row * ldc + u.pn * BM + cin) = pack8(t0 + g0 * acc[ai][bj][m][0], t1 + g1 * acc[ai][bj][m][1]); }
            EPI_FENCE();
        }
    }
};
struct EpiResF {
    static constexpr bool PERM = true, AFTER_DRAIN = false, CHAIN = false;
    const float* base; bf16_t* out; int ldc; float alpha;
    __device__ __forceinline__ void operator()(const f32x4 (&acc)[2][2][4][2], const Unit& u, int wr, int wc, int fr, int fq) const {
#pragma unroll
        for (int g0i = 0; g0i < 16; g0i += 8) {
            f32x4 t0[8], t1[8];
#pragma unroll
            for (int k = 0; k < 8; ++k) { EPI_PIECE(g0i + k) t0[k] = __builtin_nontemporal_load((const f32x4*)(base + row * ldc + u.pn * BM + cin)); t1[k] = __builtin_nontemporal_load((const f32x4*)(base + row * ldc + u.pn * BM + cin + 4)); }
            EPI_FENCE();
#pragma unroll
            for (int k = 0; k < 8; ++k) { EPI_PIECE(g0i + k)
                *(u32x4*)(out + row * ldc + u.pn * BM + cin) = pack8h(t0[k] * alpha + acc[ai][bj][m][0], t1[k] * alpha + acc[ai][bj][m][1]); }
            EPI_FENCE();
        }
    }
};
struct EpiResB {
    static constexpr bool PERM = true, AFTER_DRAIN = false, CHAIN = false;
    const bf16_t* base; bf16_t* out; int ldc; float alpha;
    __device__ __forceinline__ void operator()(const f32x4 (&acc)[2][2][4][2], const Unit& u, int wr, int wc, int fr, int fq) const {
        u32x4 bw[16];
#pragma unroll
        for (int c = 0; c < 16; ++c) { EPI_PIECE(c) bw[c] = *(const u32x4*)(base + row * ldc + u.pn * BM + cin); }
        EPI_FENCE();
#pragma unroll
        for (int c = 0; c < 16; ++c) { EPI_PIECE(c)
            f32x4 t0, t1; unpack8(bw[c], t0, t1);
            *(u32x4*)(out + row * ldc + u.pn * BM + cin) = pack8h(t0 * alpha + acc[ai][bj][m][0], t1 * alpha + acc[ai][bj][m][1]); }
    }
};
struct EpiFfn {
    static constexpr bool PERM = true, AFTER_DRAIN = false, CHAIN = false;
    bf16_t* O; int ldc;
    __device__ __forceinline__ void operator()(const f32x4 (&acc)[2][2][4][2], const Unit& u, int wr, int wc, int fr, int fq) const {
#pragma unroll
        for (int ai = 0; ai < 2; ++ai)
#pragma unroll
            for (int m = 0; m < 4; ++m) { const size_t row = (size_t)(u.pm * BM + ai * HALF + wr * 64 + m * 16 + fr);
                const f32x4 g0 = acc[ai][0][m][0], g1 = acc[ai][0][m][1], u0 = acc[ai][1][m][0], u1 = acc[ai][1][m][1];
                f32x4 v0, v1;
#pragma unroll
                for (int j = 0; j < 4; ++j) { v0[j] = g0[j] * sigm(g0[j]) * u0[j]; v1[j] = g1[j] * sigm(g1[j]) * u1[j]; }
                __builtin_nontemporal_store(pack8(v0, v1), (u32x4*)(O + row * ldc + u.pn * HALF + wc * 32 + 8 * fq)); }
    }
};
struct EpiMixChain {
    static constexpr bool PERM = true, AFTER_DRAIN = false, CHAIN = true;
    const unsigned char* GA; const unsigned char* GS; bf16_t* O; int ldc;
    __device__ __forceinline__ void operator()(f32x4 (&acc)[2][2][4][2], const Unit& u, int wr, int wc, int fr, int fq) const {
        if (u.gi == 0) {
#pragma unroll
            for (int g0i = 0; g0i < 16; g0i += 8) {
                u32x2 aw[8], sw[8];
#pragma unroll
                for (int k = 0; k < 8; ++k) { EPI_PIECE(g0i + k) aw[k] = *(const u32x2*)(GA + row * ldc + u.pn * BM + cin); sw[k] = *(const u32x2*)(GS + row * ldc + u.pn * BM + cin); }
                EPI_FENCE();
#pragma unroll
                for (int k = 0; k < 8; ++k) { EPI_PIECE(g0i + k)
#pragma unroll
                    for (int h = 0; h < 2; ++h) { const unsigned a = h ? aw[k].y : aw[k].x, sg = h ? sw[k].y : sw[k].x; f32x4 r;
#pragma unroll
                        for (int e = 0; e < 4; ++e) { const unsigned qa = (a >> (8 * e)) & 0xffu, qs = (sg >> (8 * e)) & 0xffu; r[e] = (float)qa * __builtin_amdgcn_rcpf((float)(qs > 1u ? qs : 1u)); }
                        acc[ai][bj][m][h] = acc[ai][bj][m][h] * r; } }
                EPI_FENCE();
            }
        } else {
            u32x2 sw[16];
#pragma unroll
            for (int c = 0; c < 16; ++c) { EPI_PIECE(c) sw[c] = *(const u32x2*)(GS + row * ldc + u.pn * BM + cin); }
            EPI_FENCE();
#pragma unroll
            for (int c = 0; c < 16; ++c) { EPI_PIECE(c)
                f32x4 g[2];
#pragma unroll
                for (int h = 0; h < 2; ++h) { const unsigned sg = h ? sw[c].y : sw[c].x;
#pragma unroll
                    for (int e = 0; e < 4; ++e) { const unsigned qs = (sg >> (8 * e)) & 0xffu; g[h][e] = (float)(qs > 1u ? qs : 1u) * (1.0f / 255.0f); } }
                *(u32x4*)(O + row * ldc + u.pn * BM + cin) = pack8(g[0] * acc[ai][bj][m][0], g[1] * acc[ai][bj][m][1]); }
        }
    }
};

template <class Epi, class Sched, bool ALIGN_EPI = false, bool SP2 = false>
__device__ __forceinline__ void gemm_phase(PG8_LAS unsigned char* lds, const Gemm g, const Sched& S, const Epi& E) {
    const int tid = threadIdx.x, wid = __builtin_amdgcn_readfirstlane(tid >> 6), lane = tid & 63, wr = wid >> 2, wc = wid & 3, fr = lane & 15, fq = lane >> 4;
    const int K = g.K, nt = K / BK;
    unsigned voffA[2], voffB[2];
#pragma unroll
    for (int i = 0; i < 2; ++i) { int R, C; stage_rc(tid * 16 + i * 8192, R, C); const int Rb = Epi::PERM ? ((R & ~31) + perm32(R & 31)) : R;
        voffA[i] = (unsigned)(R * K + C) * 2u; voffB[i] = (unsigned)(Rb * K + C) * 2u; }
    const size_t kstep = (size_t)(BK * 2);
    const size_t hstep = (size_t)HALF * K * 2;
    const size_t tstep = 2 * hstep;
    const unsigned ldsw = (unsigned)wid * 1024u;
    const int aoff = lds_byte(wr * 64 + fr, fq * 8), boff = lds_byte(wc * 32 + fr, fq * 8);
#define PG8_SA(b, h) (((b) * 2 + (h)) * HTB)
#define PG8_SB(b, h) ((4 + (b) * 2 + (h)) * HTB)
#define PG8_STAGE(bufoff, gbase, voff) do { _Pragma("unroll") for (int _i = 0; _i < 2; ++_i) \
        __builtin_amdgcn_global_load_lds((const unsigned*)((const char*)(gbase) + (voff)[_i]), (PG8_LAS unsigned*)(lds + (bufoff) + ldsw + _i * 8192), 16, 0, 0); } while (0)
#define PG8_LDA(dst, b, h) do { _Pragma("unroll") for (int m = 0; m < 4; ++m) _Pragma("unroll") for (int k = 0; k < 2; ++k) dst[m][k] = *(const PG8_LAS bf16x8*)(lds + PG8_SA(b, h) + aoff + m * 2048 + k * 1024); } while (0)
#define PG8_LDB(dst, b, h) do { _Pragma("unroll") for (int n = 0; n < 2; ++n) _Pragma("unroll") for (int k = 0; k < 2; ++k) dst[n][k] = *(const PG8_LAS bf16x8*)(lds + PG8_SB(b, h) + boff + n * 2048 + k * 1024); } while (0)
#define PG8_MMA(ai, bj, At, Bt) do { __builtin_amdgcn_s_setprio(1); _Pragma("unroll") for (int m = 0; m < 4; ++m) _Pragma("unroll") for (int n = 0; n < 2; ++n) _Pragma("unroll") for (int k = 0; k < 2; ++k) \
        acc[ai][bj][m][n] = __builtin_amdgcn_mfma_f32_16x16x32_bf16(Bt[n][k], At[m][k], acc[ai][bj][m][n], 0, 0, 0); __builtin_amdgcn_s_setprio(0); } while (0)
#define PG8_WAIT_V(n) asm volatile("s_waitcnt vmcnt(" #n ")" ::: "memory")
#define PG8_WAIT_L(n) asm volatile("s_waitcnt lgkmcnt(" #n ")" ::: "memory")
#define PG8_BAR __builtin_amdgcn_s_barrier()
#define PG8_SCHED __builtin_amdgcn_sched_barrier(0)
    Unit cur, nxt; int ui = 0;
    if (!S.next(0, cur)) return;
    f32x4 acc[2][2][4][2];
#pragma unroll
    for (int a = 0; a < 2; ++a)
#pragma unroll
        for (int b = 0; b < 2; ++b)
#pragma unroll
            for (int m = 0; m < 4; ++m)
#pragma unroll
                for (int n = 0; n < 2; ++n) acc[a][b][m][n] = (f32x4){0.f, 0.f, 0.f, 0.f};
    bf16x8 At[4][2], B0[2][2], B1[2][2];
    const char* cA = (const char*)(cur.gi ? g.A2 : g.A) + (size_t)cur.pm * tstep; const char* cB = (const char*)(cur.gi ? g.Bt2 : g.Bt) + (size_t)cur.pn * tstep;
    S.a_ready(cur);
    if constexpr (SP2) {
        PG8_STAGE(PG8_SB(0, 0), cB, voffB); PG8_STAGE(PG8_SB(0, 1), cB + hstep, voffB); PG8_STAGE(PG8_SA(0, 0), cA, voffA); PG8_STAGE(PG8_SA(0, 1), cA + hstep, voffA);
        if (wr == 1) PG8_BAR;
        PG8_WAIT_V(2); PG8_BAR;
        PG8_STAGE(PG8_SB(1, 0), cB + kstep, voffB); PG8_STAGE(PG8_SA(1, 0), cA + kstep, voffA); PG8_STAGE(PG8_SB(1, 1), cB + hstep + kstep, voffB);
        PG8_WAIT_V(6); PG8_BAR;
    } else {
        PG8_STAGE(PG8_SB(0, 0), cB, voffB); PG8_STAGE(PG8_SA(0, 0), cA, voffA); PG8_STAGE(PG8_SB(0, 1), cB + hstep, voffB); PG8_STAGE(PG8_SA(0, 1), cA + hstep, voffA);
        if (wr == 1) PG8_BAR;
        PG8_WAIT_V(4); PG8_BAR;
        PG8_STAGE(PG8_SB(1, 0), cB + kstep, voffB); PG8_STAGE(PG8_SA(1, 0), cA + kstep, voffA); PG8_STAGE(PG8_SB(1, 1), cB + hstep + kstep, voffB);
        PG8_WAIT_V(6); PG8_BAR;
    }
    for (;;) {
        const bool has_next = S.next(ui + 1, nxt);
        const char* nA = has_next ? (const char*)(nxt.gi ? g.A2 : g.A) + (size_t)nxt.pm * tstep : cA; const char* nB = has_next ? (const char*)(nxt.gi ? g.Bt2 : g.Bt) + (size_t)nxt.pn * tstep : cB;
        for (int t = 0; t < nt; t += 2) {
            const bool last = (t == nt - 2);
            const char* a1 = cA + (size_t)(t + 1) * kstep;
            const char* a2 = last ? nA : cA + (size_t)(t + 2) * kstep; const char* b2 = last ? nB : cB + (size_t)(t + 2) * kstep;
            const char* a3 = a2 + kstep; const char* b3 = b2 + kstep;
            if (last && has_next) S.a_ready(nxt);
            if constexpr (SP2) {
            PG8_LDB(B0, 0, 0); PG8_LDB(B1, 0, 1); PG8_SCHED; PG8_LDA(At, 0, 0); PG8_STAGE(PG8_SA(1, 1), a1 + hstep, voffA);
            PG8_WAIT_V(8); PG8_WAIT_L(0); PG8_BAR; PG8_MMA(0, 0, At, B0); PG8_MMA(0, 1, At, B1); PG8_BAR; PG8_SCHED;
            PG8_LDA(At, 0, 1); PG8_STAGE(PG8_SB(0, 0), b2, voffB); PG8_STAGE(PG8_SB(0, 1), b2 + hstep, voffB); PG8_STAGE(PG8_SA(0, 0), a2, voffA);
            PG8_WAIT_V(8); PG8_WAIT_L(0); PG8_BAR; PG8_MMA(1, 0, At, B0); PG8_MMA(1, 1, At, B1); PG8_BAR; PG8_SCHED;
            PG8_LDB(B0, 1, 0); PG8_LDB(B1, 1, 1); PG8_SCHED; PG8_LDA(At, 1, 0); PG8_STAGE(PG8_SA(0, 1), a2 + hstep, voffA);
            PG8_WAIT_V(8); PG8_WAIT_L(0); PG8_BAR; PG8_MMA(0, 0, At, B0); PG8_MMA(0, 1, At, B1); PG8_BAR; PG8_SCHED;
            PG8_LDA(At, 1, 1); PG8_STAGE(PG8_SB(1, 0), b3, voffB); PG8_STAGE(PG8_SB(1, 1), b3 + hstep, voffB); PG8_STAGE(PG8_SA(1, 0), a3, voffA);
            PG8_WAIT_V(8); PG8_WAIT_L(0); PG8_BAR; PG8_MMA(1, 0, At, B0); PG8_MMA(1, 1, At, B1); PG8_BAR; PG8_SCHED;
            } else {
            PG8_LDB(B0, 0, 0); PG8_SCHED; PG8_LDA(At, 0, 0); PG8_STAGE(PG8_SA(1, 1), a1 + hstep, voffA);
            PG8_WAIT_L(8); PG8_BAR; PG8_WAIT_L(0); PG8_MMA(0, 0, At, B0); PG8_BAR; PG8_SCHED;
            PG8_LDB(B1, 0, 1); PG8_STAGE(PG8_SB(0, 0), b2, voffB);
            PG8_BAR; PG8_WAIT_L(0); PG8_MMA(0, 1, At, B1); PG8_BAR;
            PG8_LDA(At, 0, 1); PG8_STAGE(PG8_SA(0, 0), a2, voffA);
            PG8_BAR; PG8_WAIT_L(0); PG8_MMA(1, 0, At, B0); PG8_BAR; PG8_SCHED;
            PG8_STAGE(PG8_SB(0, 1), b2 + hstep, voffB);
            PG8_WAIT_V(6); PG8_BAR; PG8_MMA(1, 1, At, B1); PG8_BAR;
            PG8_LDB(B0, 1, 0); PG8_SCHED; PG8_LDA(At, 1, 0); PG8_STAGE(PG8_SA(0, 1), a2 + hstep, voffA);
            PG8_WAIT_L(8); PG8_BAR; PG8_WAIT_L(0); PG8_MMA(0, 0, At, B0); PG8_BAR; PG8_SCHED;
            PG8_LDB(B1, 1, 1); PG8_STAGE(PG8_SB(1, 0), b3, voffB);
            PG8_BAR; PG8_WAIT_L(0); PG8_MMA(0, 1, At, B1); PG8_BAR;
            PG8_LDA(At, 1, 1); PG8_STAGE(PG8_SA(1, 0), a3, voffA);
            PG8_BAR; PG8_WAIT_L(0); PG8_MMA(1, 0, At, B0); PG8_BAR; PG8_SCHED;
            PG8_STAGE(PG8_SB(1, 1), b3 + hstep, voffB);
            PG8_WAIT_V(6); PG8_BAR; PG8_MMA(1, 1, At, B1); PG8_BAR;
            }
        }
        if constexpr (ALIGN_EPI) { if (wr == 0) PG8_BAR; }
        if constexpr (!Epi::AFTER_DRAIN) { E(acc, cur, wr, wc, fr, fq); S.done(cur); }
        if (!has_next) break;
        if (!(Epi::CHAIN && cur.gi == 0)) {
#pragma unroll
        for (int a = 0; a < 2; ++a)
#pragma unroll
            for (int b = 0; b < 2; ++b)
#pragma unroll
                for (int m = 0; m < 4; ++m)
#pragma unroll
                    for (int n = 0; n < 2; ++n) acc[a][b][m][n] = (f32x4){0.f, 0.f, 0.f, 0.f};
        }
        cur = nxt; cA = nA; cB = nB; ++ui;
        if constexpr (ALIGN_EPI) { if (wr == 1) PG8_BAR; }
    }
    PG8_WAIT_V(0);
    if constexpr (!ALIGN_EPI) { if (wr == 0) PG8_BAR; }
    PG8_BAR;
    if constexpr (Epi::AFTER_DRAIN) { E.fused(acc, cur, wr, wc, fr, fq, lds, wid, lane); S.done(cur); }
#undef PG8_SA
#undef PG8_SB
#undef PG8_STAGE
#undef PG8_LDA
#undef PG8_LDB
#undef PG8_MMA
#undef PG8_WAIT_V
#undef PG8_WAIT_L
#undef PG8_BAR
#undef PG8_SCHED
}
}

#define GAS __attribute__((address_space(1)))
#define LAS __attribute__((address_space(3)))
typedef unsigned short bf16;
typedef unsigned v4u __attribute__((ext_vector_type(4)));
typedef unsigned v2u __attribute__((ext_vector_type(2)));
typedef float f32x4 __attribute__((ext_vector_type(4)));
typedef float f32x16 __attribute__((ext_vector_type(16)));
typedef short bf16x8 __attribute__((ext_vector_type(8)));
using pg8::cvt_pk_bf16; using pg8::bf_lo; using pg8::bf_hi; using pg8::sigm;

constexpr int NWAVES = 8, NTHR = 512;
constexpr int M = 16384, D = 2048, NAW = 1024, S5W = 1024, DFF = 5632;
constexpr int NPROJ = 7168;
constexpr int GW = 64, NROWS = 256, NH = 8, HD = 128;
constexpr int SL = 256, NS = M / SL, NBLK = SL / 16;
constexpr float LN_EPS = 1e-5f;
constexpr float ALPHA = 1.189207115002721f;
constexpr float LOG2E = 1.4426950408889634f;
constexpr float QSCALE = 0.08838834764831845f * LOG2E;

constexpr size_t MiB = 1u << 20;
constexpr size_t WS_CTL = 0, CTL_ZERO_BYTES = 16384;
constexpr size_t WS_LAMB = 1 * MiB;
constexpr size_t WS_BMAT = 1 * MiB + 65536;
constexpr size_t WS_CMAT = 2 * MiB;
constexpr size_t WS_EST = 3 * MiB;
constexpr size_t WS_WIN = 8 * MiB, WS_WV = 36 * MiB, WS_WNA = 40 * MiB, WS_WGLU = 44 * MiB, WS_WS5O = 46 * MiB, WS_WOUT = 50 * MiB, WS_WGU = 58 * MiB, WS_WDN = 102 * MiB;
constexpr size_t WS_GA = 124 * MiB, WS_GS = 188 * MiB, WS_PRE1 = 124 * MiB, WS_PRE2 = 124 * MiB, WS_HH = 188 * MiB;
constexpr size_t WS_XB = 252 * MiB, WS_ATT = 252 * MiB, WS_YS2 = 284 * MiB, WS_HB = 252 * MiB;
constexpr size_t WS_Q = 316 * MiB, WS_U = 348 * MiB, WS_K = 380 * MiB, WS_VT = 412 * MiB;
constexpr size_t WS_YS = 380 * MiB, WS_GATED = 316 * MiB, WS_ACT = 316 * MiB, WS_END = 492 * MiB;
constexpr int LDS_BYTES = 147456;

#define LDS_WAIT() asm volatile("s_waitcnt lgkmcnt(0)" ::: "memory")
#define VM_WAIT() asm volatile("s_waitcnt vmcnt(0)" ::: "memory")
__device__ __forceinline__ float wave_sum(float v) {
#pragma unroll
    for (int o = 1; o < 64; o <<= 1) v += __shfl_xor(v, o);
    return v;
}
__device__ __forceinline__ float gelu_tanh(float x) { const float z = 0.7978845608028654f * (x + 0.044715f * x * x * x); return x * sigm(2.0f * z); }

__device__ __forceinline__ void p0_transpose_item(const float* W, int K, int N, bf16* WT, int out_row0, int kb, int nb, LAS float* scr, int lane) {
    const int k0 = 64 * kb, n0 = 32 * nb;
    float tmp[32];
    const float* wp = W + (size_t)(k0 + (lane >> 5)) * N + n0 + (lane & 31);
#pragma unroll
    for (int i = 0; i < 32; ++i) tmp[i] = __builtin_nontemporal_load(wp + (size_t)(2 * i) * N);
#pragma unroll
    for (int i = 0; i < 32; ++i) scr[(2 * i + (lane >> 5)) * 33 + (lane & 31)] = tmp[i];
    LDS_WAIT(); asm volatile("" ::: "memory");
    const int c = lane & 7;
#pragma unroll
    for (int j = 0; j < 4; ++j) { const int n = (lane >> 3) + 8 * j; const LAS float* s = scr + (8 * c) * 33 + n;
        v4u o; o.x = cvt_pk_bf16(s[0 * 33], s[1 * 33]); o.y = cvt_pk_bf16(s[2 * 33], s[3 * 33]); o.z = cvt_pk_bf16(s[4 * 33], s[5 * 33]); o.w = cvt_pk_bf16(s[6 * 33], s[7 * 33]);
        *(v4u*)(WT + (size_t)(out_row0 + n) * K + k0 + 8 * c) = o; }
    LDS_WAIT(); asm volatile("" ::: "memory");
}
__device__ __forceinline__ double dexp_small(double x) {
    const double y = x * (1.0 / 128.0); double t = 1.0 / 479001600.0;
    t = t * y + 1.0 / 39916800.0; t = t * y + 1.0 / 3628800.0; t = t * y + 1.0 / 362880.0; t = t * y + 1.0 / 40320.0; t = t * y + 1.0 / 5040.0; t = t * y + 1.0 / 720.0;
    t = t * y + 1.0 / 120.0; t = t * y + 1.0 / 24.0; t = t * y + 1.0 / 6.0; t = t * y + 0.5; t = t * y + 1.0; t = t * y + 1.0;
#pragma unroll
    for (int i = 0; i < 7; ++i) t = t * t;
    return t;
}
__device__ __forceinline__ void dsincos_small(double th, double& sn, double& cs) {
    const double kf = __builtin_rint(th * 0.6366197723675814); const int k = (int)kf;
    double r = th - kf * 1.5707963267948966; r = r - kf * 6.123233995736766e-17;
    const double r2 = r * r;
    double s = -1.0 / 355687428096000.0;
    s = s * r2 + 1.0 / 1307674368000.0; s = s * r2 - 1.0 / 6227020800.0; s = s * r2 + 1.0 / 39916800.0; s = s * r2 - 1.0 / 362880.0; s = s * r2 + 1.0 / 5040.0; s = s * r2 - 1.0 / 120.0; s = s * r2 + 1.0 / 6.0;
    s = r - r * r2 * s;
    double c = 1.0 / 20922789888000.0;
    c = c * r2 - 1.0 / 87178291200.0; c = c * r2 + 1.0 / 479001600.0; c = c * r2 - 1.0 / 3628800.0; c = c * r2 + 1.0 / 40320.0; c = c * r2 - 1.0 / 720.0; c = c * r2 + 1.0 / 24.0; c = c * r2 - 0.5; c = c * r2 + 1.0;
    const int q = k & 3;
    sn = (q == 0) ? s : (q == 1) ? c : (q == 2) ? -s : -c;
    cs = (q == 0) ? c : (q == 1) ? -s : (q == 2) ? -c : s;
}

#define XB_TMO      128
#define XB_XCNT(j)  (256  + 64 * (j))
#define XB_XSUB(j)  (1280 + 64 * (j))
#define XB_XGEN(j)  (2304 + 64 * (j))
#define XB_TOP      3328
#define XB_TOPGEN   3392
#define XCD_BAR_WORDS 3456
#define XB_SPIN_CAP (1u << 18)

__device__ __forceinline__ unsigned xb_ld(unsigned* p)              { return __hip_atomic_load(p, __ATOMIC_RELAXED, __HIP_MEMORY_SCOPE_AGENT); }
__device__ __forceinline__ unsigned xb_add(unsigned* p, unsigned v) { return __hip_atomic_fetch_add(p, v, __ATOMIC_RELAXED, __HIP_MEMORY_SCOPE_AGENT); }
__device__ __forceinline__ unsigned xb_xcc_id() { return (unsigned)__builtin_amdgcn_s_getreg((3 << 11) | 20) & 0xFu; }
#define XB_SPIN(cond, bar) do { unsigned _sp = 0; while (cond) { __builtin_amdgcn_s_sleep(1); \
    if ((++_sp & 255u) == 0u) { if (xb_ld(&(bar)[XB_TMO])) break; if (_sp > XB_SPIN_CAP) { atomicAdd(&(bar)[XB_TMO], 1u); break; } } } } while (0)

struct XcdBarrier {
    unsigned* bar; unsigned x;
    volatile LAS unsigned* st;
};

__device__ __forceinline__ XcdBarrier xcd_barrier_post(unsigned* bar, volatile LAS unsigned* st) {
    XcdBarrier b; b.bar = bar; b.x = xb_xcc_id(); b.st = st;
    if (threadIdx.x == 0) (void)xb_add(&bar[XB_XCNT(b.x)], 1u);
    return b;
}
__device__ __forceinline__ void xcd_barrier_complete(unsigned* bar, unsigned x, unsigned& nloc, unsigned& nx) {
    const unsigned G = gridDim.x * gridDim.y * gridDim.z;
    unsigned sum, cnt, mine, sp = 0u;
    for (;;) {
        sum = 0u; cnt = 0u; mine = 0u;
#pragma unroll
        for (unsigned j = 0; j < 16; ++j) { const unsigned c = xb_ld(&bar[XB_XCNT(j)]); sum += c; cnt += (c > 0u) ? 1u : 0u; mine = (j == x) ? c : mine; }
        if (sum == G) break;
        __builtin_amdgcn_s_sleep(1);
        if ((++sp & 255u) == 0u) { if (xb_ld(&bar[XB_TMO])) break; if (sp > XB_SPIN_CAP) { atomicAdd(&bar[XB_TMO], 1u); break; } }
    }
    nloc = mine > 0u ? mine : 1u; nx = cnt > 0u ? cnt : 1u;
}

__device__ __forceinline__ void xcd_barrier(const XcdBarrier& b) {
    asm volatile("s_waitcnt vmcnt(0)" ::: "memory");
    __syncthreads();
    if (threadIdx.x == 0) {
        unsigned* bar = b.bar;
        __builtin_amdgcn_s_waitcnt(0);
        unsigned nloc = b.st[0], nx = b.st[1];
        if (nloc == 0u) { xcd_barrier_complete(bar, b.x, nloc, nx); b.st[0] = nloc; b.st[1] = nx; }
        const unsigned old = xb_add(&bar[XB_XSUB(b.x)], 1u);
        const unsigned gen = old / nloc;
        if (old + 1u == (gen + 1u) * nloc) {
            __builtin_amdgcn_fence(__ATOMIC_RELEASE, "agent");
            asm volatile("s_waitcnt vmcnt(0)" ::: "memory");
            const unsigned og = xb_add(&bar[XB_TOP], 1u);
            const unsigned tg = og / nx;
            if (og + 1u == (tg + 1u) * nx) xb_add(&bar[XB_TOPGEN], 1u);
            else XB_SPIN(xb_ld(&bar[XB_TOPGEN]) == tg, bar);
            __builtin_amdgcn_fence(__ATOMIC_ACQUIRE, "agent");
            xb_add(&bar[XB_XGEN(b.x)], 1u);
            asm volatile("s_waitcnt vmcnt(0)" ::: "memory");
        } else {
            XB_SPIN(xb_ld(&bar[XB_XGEN(b.x)]) == gen, bar);
            __builtin_amdgcn_fence(__ATOMIC_ACQUIRE, "agent");
            asm volatile("s_waitcnt vmcnt(0)" ::: "memory");
        }
    }
    __syncthreads();
}

struct Args { const float* in[24]; float* out; unsigned char* ws; int ph_lo, ph_hi; };

#define MFMA32(a, b, c) __builtin_amdgcn_mfma_f32_32x32x16_bf16((a), (b), (c), 0, 0, 0)
#define MFMA16(a, b, c) __builtin_amdgcn_mfma_f32_16x16x32_bf16((a), (b), (c), 0, 0, 0)

template <bool FINAL>
__device__ __forceinline__ void s5_run(const unsigned char* ws, const bf16* U, int sp, int g, int dir, LAS unsigned char* wl, int lane,
                                       float* YF, bf16* YS, const float* s5d) {
    const int n = lane & 31, hi = lane >> 5;
    const int dg = dir * 64 + g;
    const float* LAMB = (const float*)(ws + WS_LAMB);
    const bf16* BMAT = (const bf16*)(ws + WS_BMAT);
    const bf16* CMAT = (const bf16*)(ws + WS_CMAT);
    f32x4* EST = (f32x4*)(ws + WS_EST);
    const float lr0 = LAMB[(dg * 64 + n) * 2], li0 = LAMB[(dg * 64 + n) * 2 + 1], lr1 = LAMB[(dg * 64 + 32 + n) * 2], li1 = LAMB[(dg * 64 + 32 + n) * 2 + 1];
    bf16x8 Bf[4];
#pragma unroll
    for (int T = 0; T < 4; ++T) Bf[T] = *(const bf16x8*)(BMAT + ((size_t)(dg * 128 + 32 * T + n)) * 16 + hi * 8);
    const int sseg = FINAL ? (dir ? NS - 1 - (2 * sp + hi) : 2 * sp + hi) : 2 * sp + hi;
    float sr0 = 0.f, si0 = 0.f, sr1 = 0.f, si1 = 0.f;
    if (FINAL) {
        float ar0 = lr0, ai0 = li0, ar1 = lr1, ai1 = li1;
#pragma unroll
        for (int i = 0; i < 8; ++i) { const float t0 = ar0 * ar0 - ai0 * ai0, u0 = 2.f * ar0 * ai0, t1 = ar1 * ar1 - ai1 * ai1, u1 = 2.f * ar1 * ai1; ar0 = t0; ai0 = u0; ar1 = t1; ai1 = u1; }
        const int smax = dir ? NS - 1 - 2 * sp : 2 * sp + 1;
        const f32x4* E = EST + (size_t)dg * NS * 32 + n;
        for (int s0 = 0; s0 < smax; s0 += 16) {
            f32x4 e[16];
#pragma unroll
            for (int j = 0; j < 16; ++j) { const int idx = (s0 + j) < NS ? (s0 + j) : NS - 1; e[j] = E[(size_t)idx * 32]; }
#pragma unroll
            for (int j = 0; j < 16; ++j) if (s0 + j < sseg) {
                const float nr0 = ar0 * sr0 - ai0 * si0 + e[j][0], ni0 = ar0 * si0 + ai0 * sr0 + e[j][1];
                const float nr1 = ar1 * sr1 - ai1 * si1 + e[j][2], ni1 = ar1 * si1 + ai1 * sr1 + e[j][3];
                sr0 = nr0; si0 = ni0; sr1 = nr1; si1 = ni1; }
        }
    }
    bf16x8 Cf[4];
    if (FINAL) {
#pragma unroll
        for (int ks = 0; ks < 4; ++ks) Cf[ks] = *(const bf16x8*)(CMAT + ((size_t)(dg * 16 + (lane & 15))) * 128 + 32 * ks + (lane >> 4) * 8);
    }
    const int m = lane & 31, hm = (m >> 2) & 1, im = 4 * (m >> 3) + (m & 3);
    const int segm = FINAL ? (dir ? NS - 1 - (2 * sp + hm) : 2 * sp + hm) : 2 * sp + hm;
    const f32x16 zero16 = {0.f, 0.f, 0.f, 0.f, 0.f, 0.f, 0.f, 0.f, 0.f, 0.f, 0.f, 0.f, 0.f, 0.f, 0.f, 0.f};
    float dsk[4] = {0.f, 0.f, 0.f, 0.f};
    if (FINAL && dir == 1) {
#pragma unroll
        for (int j = 0; j < 4; ++j) dsk[j] = s5d[g * 16 + 4 * (lane >> 4) + j];
    }
    const int tau0 = segm * SL + im;
    const bf16* up0 = U + (size_t)(dir ? (M - 1 - tau0) : tau0) * S5W + g * 16 + hi * 8;
    const long ustep = dir ? -16L * S5W : 16L * S5W;
    bf16x8 ufr[2];
#pragma unroll
    for (int u = 0; u < 2; ++u) ufr[u] = *(const bf16x8*)(up0 + (long)u * ustep);
    const int nn = lane & 15, q4 = lane >> 4;
    const size_t obase = (size_t)(2 * sp * SL + nn) * S5W + g * 16 + 4 * q4;
    v2u yfr[2][2]; v2u uwr[2][2];
    if (FINAL && dir == 1) {
#pragma unroll
        for (int b = 0; b < 2; ++b)
#pragma unroll
            for (int mt = 0; mt < 2; ++mt) { const size_t off = obase + (size_t)(mt * SL + 16 * (NBLK - 1 - b)) * S5W; yfr[b][mt] = *(const v2u*)((const bf16*)YF + off); uwr[b][mt] = *(const v2u*)(U + off); }
    }
    for (int b4 = 0; b4 < NBLK; b4 += 2)
#pragma unroll
    for (int u = 0; u < 2; ++u) {
        const int b = b4 + u;
        const bf16x8 uf = ufr[u];
        if (b + 2 < NBLK) ufr[u] = *(const bf16x8*)(up0 + (long)(b + 2) * ustep);
        f32x16 a0 = MFMA32(uf, Bf[0], zero16), a1 = MFMA32(uf, Bf[1], zero16), a2 = MFMA32(uf, Bf[2], zero16), a3 = MFMA32(uf, Bf[3], zero16);
#pragma unroll
        for (int i = 0; i < 16; ++i) {
            const float nr0 = lr0 * sr0 - li0 * si0 + a0[i], ni0 = lr0 * si0 + li0 * sr0 + a2[i];
            const float nr1 = lr1 * sr1 - li1 * si1 + a1[i], ni1 = lr1 * si1 + li1 * sr1 + a3[i];
            sr0 = nr0; si0 = ni0; sr1 = nr1; si1 = ni1;
            if (FINAL) { LAS unsigned* rowp = (LAS unsigned*)(wl + (hi * 16 + i) * 272);
                rowp[n] = cvt_pk_bf16(sr0, si0); rowp[32 + n] = cvt_pk_bf16(sr1, si1); }
        }
        if (FINAL) {
#pragma unroll
            for (int mt = 0; mt < 2; ++mt) {
                f32x4 y = {0.f, 0.f, 0.f, 0.f};
                const int srow = mt * 16 + (dir ? 15 - nn : nn);
#pragma unroll
                for (int ks = 0; ks < 4; ++ks) { const bf16x8 sf = *(const LAS bf16x8*)(wl + srow * 272 + (32 * ks + q4 * 8) * 2); y = MFMA16(Cf[ks], sf, y); }
                const int bb = dir ? (NBLK - 1 - b) : b;
                const size_t off = obase + (size_t)(mt * SL + 16 * bb) * S5W;
                if (dir == 0) { v2u yw; yw.x = cvt_pk_bf16(y[0], y[1]); yw.y = cvt_pk_bf16(y[2], y[3]); *(v2u*)((bf16*)YF + off) = yw; }
                else {
                    const v2u yq = yfr[u & 1][mt]; const f32x4 yf = {bf_lo(yq.x), bf_hi(yq.x), bf_lo(yq.y), bf_hi(yq.y)};
                    const v2u uw = uwr[u & 1][mt];
                    float o[4];
                    o[0] = yf[0] + y[0] + dsk[0] * bf_lo(uw.x); o[1] = yf[1] + y[1] + dsk[1] * bf_hi(uw.x);
                    o[2] = yf[2] + y[2] + dsk[2] * bf_lo(uw.y); o[3] = yf[3] + y[3] + dsk[3] * bf_hi(uw.y);
#pragma unroll
                    for (int j = 0; j < 4; ++j) o[j] = gelu_tanh(o[j]);
                    v2u w; w.x = cvt_pk_bf16(o[0], o[1]); w.y = cvt_pk_bf16(o[2], o[3]);
                    *(v2u*)(YS + off) = w;
                    if (b + 2 < NBLK) { const size_t off2 = obase + (size_t)(mt * SL + 16 * (NBLK - 1 - (b + 2))) * S5W; yfr[u & 1][mt] = *(const v2u*)((const bf16*)YF + off2); uwr[u & 1][mt] = *(const v2u*)(U + off2); }
                }
            }
        }
        __builtin_amdgcn_sched_barrier(0);
    }
    if (!FINAL) EST[((size_t)dg * NS + sseg) * 32 + n] = (f32x4){sr0, si0, sr1, si1};
}

__device__ __forceinline__ void s5_pass1_pair(const unsigned char* ws, const bf16* U, int spA, int spB, int g, int dir, int lane) {
    const int n = lane & 31, hi = lane >> 5;
    const int dg = dir * 64 + g;
    const float* LAMB = (const float*)(ws + WS_LAMB);
    const bf16* BMAT = (const bf16*)(ws + WS_BMAT);
    f32x4* EST = (f32x4*)(ws + WS_EST);
    const int m = lane & 31, hm = (m >> 2) & 1, im = 4 * (m >> 3) + (m & 3);
    const int tauA = (2 * spA + hm) * SL + im, tauB = (2 * spB + hm) * SL + im;
    const bf16* upA = U + (size_t)(dir ? (M - 1 - tauA) : tauA) * S5W + g * 16 + hi * 8;
    const bf16* upB = U + (size_t)(dir ? (M - 1 - tauB) : tauB) * S5W + g * 16 + hi * 8;
    const long ustep = dir ? -16L * S5W : 16L * S5W;
    bf16x8 ufA[2], ufB[2];
#pragma unroll
    for (int u = 0; u < 2; ++u) { ufA[u] = *(const bf16x8*)(upA + (long)u * ustep); ufB[u] = *(const bf16x8*)(upB + (long)u * ustep); }
    const float lr0 = LAMB[(dg * 64 + n) * 2], li0 = LAMB[(dg * 64 + n) * 2 + 1], lr1 = LAMB[(dg * 64 + 32 + n) * 2], li1 = LAMB[(dg * 64 + 32 + n) * 2 + 1];
    bf16x8 Bf[4];
#pragma unroll
    for (int T = 0; T < 4; ++T) Bf[T] = *(const bf16x8*)(BMAT + ((size_t)(dg * 128 + 32 * T + n)) * 16 + hi * 8);
    const f32x16 zero16 = {0.f, 0.f, 0.f, 0.f, 0.f, 0.f, 0.f, 0.f, 0.f, 0.f, 0.f, 0.f, 0.f, 0.f, 0.f, 0.f};
    float ar0 = 0.f, ai0 = 0.f, ar1 = 0.f, ai1 = 0.f, br0 = 0.f, bi0 = 0.f, br1 = 0.f, bi1 = 0.f;
    for (int b2 = 0; b2 < NBLK; b2 += 2)
#pragma unroll
    for (int u = 0; u < 2; ++u) {
        const int b = b2 + u;
        const bf16x8 fa = ufA[u], fb = ufB[u];
        if (b + 2 < NBLK) { ufA[u] = *(const bf16x8*)(upA + (long)(b + 2) * ustep); ufB[u] = *(const bf16x8*)(upB + (long)(b + 2) * ustep); }
        f32x16 a0 = MFMA32(fa, Bf[0], zero16), a1 = MFMA32(fa, Bf[1], zero16), a2 = MFMA32(fa, Bf[2], zero16), a3 = MFMA32(fa, Bf[3], zero16);
        f32x16 c0 = MFMA32(fb, Bf[0], zero16), c1 = MFMA32(fb, Bf[1], zero16), c2 = MFMA32(fb, Bf[2], zero16), c3 = MFMA32(fb, Bf[3], zero16);
#pragma unroll
        for (int i = 0; i < 16; ++i) {
            const float nr0 = lr0 * ar0 - li0 * ai0 + a0[i], ni0 = lr0 * ai0 + li0 * ar0 + a2[i];
            const float nr1 = lr1 * ar1 - li1 * ai1 + a1[i], ni1 = lr1 * ai1 + li1 * ar1 + a3[i];
            const float mr0 = lr0 * br0 - li0 * bi0 + c0[i], mi0 = lr0 * bi0 + li0 * br0 + c2[i];
            const float mr1 = lr1 * br1 - li1 * bi1 + c1[i], mi1 = lr1 * bi1 + li1 * br1 + c3[i];
            ar0 = nr0; ai0 = ni0; ar1 = nr1; ai1 = ni1; br0 = mr0; bi0 = mi0; br1 = mr1; bi1 = mi1;
        }
        __builtin_amdgcn_sched_barrier(0);
    }
    EST[((size_t)dg * NS + 2 * spA + hi) * 32 + n] = (f32x4){ar0, ai0, ar1, ai1};
    EST[((size_t)dg * NS + 2 * spB + hi) * 32 + n] = (f32x4){br0, bi0, br1, bi1};
}

constexpr int AT_KSTR = 272, AT_VSTR = 144, AT_KBUF = 64 * AT_KSTR, AT_VBUF = 128 * AT_VSTR, AT_STAGE = AT_KBUF + AT_VBUF;
__device__ __forceinline__ void attn_step(const LAS unsigned char* kp, const LAS unsigned char* vp0, const LAS float* rpr, const bf16x8 (&Qf)[4], const int (&bofs)[8], f32x4 (&O)[8], float& mrun, float& lsum) {
    float bias[8];
#pragma unroll
    for (int s = 0; s < 8; ++s) bias[s] = rpr[bofs[s]];
    f32x4 S[2];
#pragma unroll
    for (int nt = 0; nt < 2; ++nt) { f32x4 s = {0.f, 0.f, 0.f, 0.f};
#pragma unroll
        for (int ks = 0; ks < 4; ++ks) { const bf16x8 kf = *(const LAS bf16x8*)(kp + 16 * nt * AT_KSTR + ks * 64); s = MFMA16(kf, Qf[ks], s); }
        S[nt] = s; }
    float v[8]; float ml = -1e30f;
#pragma unroll
    for (int s = 0; s < 8; ++s) { v[s] = S[s >> 2][s & 3] + bias[s]; ml = fmaxf(ml, v[s]); }
    ml = fmaxf(ml, __shfl_xor(ml, 16)); ml = fmaxf(ml, __shfl_xor(ml, 32));
    const float mnew = fmaxf(mrun, ml), al = __builtin_amdgcn_exp2f(mrun - mnew); mrun = mnew;
    float ps = 0.f;
#pragma unroll
    for (int s = 0; s < 8; ++s) { v[s] = __builtin_amdgcn_exp2f(v[s] - mnew); ps += v[s]; }
    lsum = lsum * al + ps;
    v4u pw; pw.x = cvt_pk_bf16(v[0], v[1]); pw.y = cvt_pk_bf16(v[2], v[3]); pw.z = cvt_pk_bf16(v[4], v[5]); pw.w = cvt_pk_bf16(v[6], v[7]);
    const bf16x8 pf = __builtin_bit_cast(bf16x8, pw);
#pragma unroll
    for (int dt = 0; dt < 8; ++dt) {
        const LAS unsigned char* vp = vp0 + 16 * dt * AT_VSTR;
        const v2u lo = *(const LAS v2u*)vp, hi2 = *(const LAS v2u*)(vp + 32);
        v4u vw; vw.x = lo.x; vw.y = lo.y; vw.z = hi2.x; vw.w = hi2.y;
        O[dt] = MFMA16(__builtin_bit_cast(bf16x8, vw), pf, O[dt] * al);
    }
}
__device__ __forceinline__ void attn_block(const bf16* Q, const bf16* K, const bf16* VT, bf16* ATT, const float* rpb, int rp4, int h, LAS unsigned char* lds, int wave, int lane, int tid) {
    const int n = lane & 15, q4 = lane >> 4, rw = wave >> 2, j = wave & 3;
    const int rA = 4 * rp4 + rw, rB = rA + 2;
    const int r0A = rA < 4 ? 0 : (rA > NROWS - 4 ? NROWS - 8 : rA - 4), r0B = rB < 4 ? 0 : (rB > NROWS - 4 ? NROWS - 8 : rB - 4);
    const int ra = 4 * rp4, rb = 4 * rp4 + 3;
    const int kmin = ra < 4 ? 0 : (ra > NROWS - 4 ? NROWS - 8 : ra - 4);
    const int kmax = (rb < 4 ? 0 : (rb > NROWS - 4 ? NROWS - 8 : rb - 4)) + 7;
    const int nkr = kmax - kmin + 1;
    const int kc0 = (j == 0) ? 0 : (j == 1) ? 8 : (j == 2) ? 24 : 32;
    const int c = 16 * j + n;
    const int cs = c < 8 ? 0 : (c > 56 ? 48 : c - 8);
    const size_t tqA = (size_t)rA * GW + c, tqB = (size_t)rB * GW + c;
    const bf16* kg[2]; const bf16* vg[2]; int kl[2], vl[2];
#pragma unroll
    for (int i = 0; i < 2; ++i) { const int p = tid + 512 * i;
        kg[i] = K + (size_t)(p >> 4) * NAW + h * HD + (p & 15) * 8 + (size_t)kmin * GW * NAW; kl[i] = (p >> 4) * AT_KSTR + (p & 15) * 16;
        vg[i] = VT + (size_t)(h * HD + (p >> 3)) * M + (p & 7) * 8 + (size_t)kmin * GW; vl[i] = AT_KBUF + (p >> 3) * AT_VSTR + (p & 7) * 16; }
    v4u kA[2], vA[2], kB[2], vB[2];
#define AT_LOAD(KR, VR, st) do { _Pragma("unroll") for (int i = 0; i < 2; ++i) { KR[i] = *(const v4u*)(kg[i] + (size_t)(st) * GW * NAW); VR[i] = *(const v4u*)(vg[i] + (size_t)(st) * GW); } } while (0)
#define AT_WRITE(KR, VR, buf) do { LAS unsigned char* nb_ = lds + (buf) * AT_STAGE; _Pragma("unroll") for (int i = 0; i < 2; ++i) { *(LAS v4u*)(nb_ + kl[i]) = KR[i]; *(LAS v4u*)(nb_ + vl[i]) = VR[i]; } } while (0)
    AT_LOAD(kA, vA, 0);
    AT_LOAD(kB, vB, 1);
    bf16x8 QfA[4], QfB[4];
#pragma unroll
    for (int ks = 0; ks < 4; ++ks) { QfA[ks] = *(const bf16x8*)(Q + tqA * NAW + h * HD + 32 * ks + q4 * 8); QfB[ks] = *(const bf16x8*)(Q + tqB * NAW + h * HD + 32 * ks + q4 * 8); }
    int bofs[8];
#pragma unroll
    for (int s = 0; s < 8; ++s) { const int kc = kc0 + 16 * (s >> 2) + 4 * q4 + (s & 3); const bool val = (kc >= cs) && (kc < cs + 16); int bi = kc - c + 15; bi = bi < 0 ? 0 : (bi > 30 ? 30 : bi); bofs[s] = val ? bi : 31; asm volatile("" : "+v"(bofs[s])); }
    const LAS unsigned char* kp0 = lds + (kc0 + n) * AT_KSTR + q4 * 16; const LAS unsigned char* vp0 = lds + AT_KBUF + n * AT_VSTR + (kc0 + 4 * q4) * 2;
    asm volatile("" : "+v"(kp0), "+v"(vp0));
    f32x4 OA[8], OB[8];
#pragma unroll
    for (int dt = 0; dt < 8; ++dt) { OA[dt] = (f32x4){0.f, 0.f, 0.f, 0.f}; OB[dt] = (f32x4){0.f, 0.f, 0.f, 0.f}; }
    float mA = -1e30f, lA = 0.f, mB = -1e30f, lB = 0.f;
    LAS float* rpb_h = (LAS float*)(lds + 2 * AT_STAGE);
    if (tid < 15 * 32) rpb_h[tid] = (tid & 31) < 31 ? rpb[(size_t)h * 15 * 31 + (tid >> 5) * 31 + (tid & 31)] * LOG2E : -1e30f;
    AT_WRITE(kA, vA, 0);
    __syncthreads();
    const int nst = (nkr + 1) & ~1, lastst = nkr - 1;
    for (int it = 0; it < nst; it += 2) {
        { const int st = it + 2 < lastst ? it + 2 : lastst; AT_LOAD(kA, vA, st); }
        { const int kr = kmin + it;
          if (kr >= r0A && kr <= r0A + 7) attn_step(kp0, vp0, rpb_h + (kr - rA + 7) * 32, QfA, bofs, OA, mA, lA);
          if (kr >= r0B && kr <= r0B + 7) attn_step(kp0, vp0, rpb_h + (kr - rB + 7) * 32, QfB, bofs, OB, mB, lB); }
        AT_WRITE(kB, vB, 1);
        __syncthreads();
        { const int st = it + 3 < lastst ? it + 3 : lastst; AT_LOAD(kB, vB, st); }
        { const int kr = kmin + it + 1;
          if (kr >= r0A && kr <= r0A + 7 && it + 1 < nkr) attn_step(kp0 + AT_STAGE, vp0 + AT_STAGE, rpb_h + (kr - rA + 7) * 32, QfA, bofs, OA, mA, lA);
          if (kr >= r0B && kr <= r0B + 7 && it + 1 < nkr) attn_step(kp0 + AT_STAGE, vp0 + AT_STAGE, rpb_h + (kr - rB + 7) * 32, QfB, bofs, OB, mB, lB); }
        AT_WRITE(kA, vA, 0);
        __syncthreads();
    }
#undef AT_LOAD
#undef AT_WRITE
    lA += __shfl_xor(lA, 16); lA += __shfl_xor(lA, 32); lB += __shfl_xor(lB, 16); lB += __shfl_xor(lB, 32);
    const float invA = 1.0f / lA, invB = 1.0f / lB;
#pragma unroll
    for (int dt = 0; dt < 8; ++dt) {
        v2u w; w.x = cvt_pk_bf16(OA[dt][0] * invA, OA[dt][1] * invA); w.y = cvt_pk_bf16(OA[dt][2] * invA, OA[dt][3] * invA);
        *(v2u*)(ATT + tqA * NAW + h * HD + 16 * dt + 4 * q4) = w;
        v2u x; x.x = cvt_pk_bf16(OB[dt][0] * invB, OB[dt][1] * invB); x.y = cvt_pk_bf16(OB[dt][2] * invB, OB[dt][3] * invB);
        *(v2u*)(ATT + tqB * NAW + h * HD + 16 * dt + 4 * q4) = x;
    }
}

__device__ __forceinline__ void ln_row_compute(const v4u (&w)[4], float* orow, bf16* brow, bf16* hrow, const f32x4 (&gg)[8], const f32x4 (&bb)[8], int lane) {
    f32x4 v[8]; float s = 0.f;
#pragma unroll
    for (int jj = 0; jj < 4; ++jj) pg8::unpack8h(w[jj], v[2 * jj], v[2 * jj + 1]);
#pragma unroll
    for (int jj = 0; jj < 8; ++jj) s += (v[jj][0] + v[jj][1]) + (v[jj][2] + v[jj][3]);
    const float mean = wave_sum(s) * (1.f / D); float s2 = 0.f;
#pragma unroll
    for (int jj = 0; jj < 8; ++jj) { v[jj] = v[jj] - mean; s2 += (v[jj][0] * v[jj][0] + v[jj][1] * v[jj][1]) + (v[jj][2] * v[jj][2] + v[jj][3] * v[jj][3]); }
    const float rstd = 1.f / sqrtf(wave_sum(s2) * (1.f / D) + LN_EPS);
#pragma unroll
    for (int jj = 0; jj < 4; ++jj) {
        const int e4 = 2 * (64 * jj + lane);
        const f32x4 o0 = v[2 * jj] * rstd * gg[2 * jj] + bb[2 * jj], o1 = v[2 * jj + 1] * rstd * gg[2 * jj + 1] + bb[2 * jj + 1];
        if (orow) { __builtin_nontemporal_store(o0, (f32x4*)orow + e4); __builtin_nontemporal_store(o1, (f32x4*)orow + e4 + 1); }
        if (brow) { ((v4u*)brow)[64 * jj + lane] = pg8::pack8(o0, o1); }
        if (hrow) { ((v4u*)hrow)[64 * jj + lane] = pg8::pack8h(o0, o1); }
    }
}
__device__ __forceinline__ void ln_phase(const bf16* X, float* OF, bf16* OB, bf16* OH, const float* gam, const float* bet, int gw, int NGW, int lane) {
    f32x4 gg[8], bb[8];
#pragma unroll
    for (int jj = 0; jj < 4; ++jj) { const int e4 = 2 * (64 * jj + lane); gg[2 * jj] = ((const f32x4*)gam)[e4]; gg[2 * jj + 1] = ((const f32x4*)gam)[e4 + 1]; bb[2 * jj] = ((const f32x4*)bet)[e4]; bb[2 * jj + 1] = ((const f32x4*)bet)[e4 + 1]; }
    for (int base = gw; base < M; base += 4 * NGW) {
        v4u w[4][4];
#pragma unroll
        for (int k = 0; k < 4; ++k) { const int row = base + k * NGW < M ? base + k * NGW : M - 1;
#pragma unroll
            for (int jj = 0; jj < 4; ++jj) w[k][jj] = __builtin_nontemporal_load((const v4u*)(X + (size_t)row * D) + 64 * jj + lane); }
#pragma unroll
        for (int k = 0; k < 4; ++k) { const int row = base + k * NGW;
            if (row < M) ln_row_compute(w[k], OF ? OF + (size_t)row * D : nullptr, OB ? OB + (size_t)row * D : nullptr, OH ? OH + (size_t)row * D : nullptr, gg, bb, lane); }
    }
}

constexpr int TI_IN = 32 * 256, TI_NA = 16 * 64, TI_GLU = 16 * 32, TI_S5O = 16 * 64, TI_OUT = 32 * 64, TI_FG = 32 * 176, TI_FD = 88 * 64;
constexpr int TI_ALL = TI_IN + TI_NA + TI_GLU + TI_S5O + TI_OUT + 2 * TI_FG + TI_FD;
__device__ __forceinline__ void transpose_item_any(const Args& args, unsigned char* ws, int it, LAS float* scr, int lane) {
    bf16* WinT = (bf16*)(ws + WS_WIN); bf16* WvT = (bf16*)(ws + WS_WV); bf16* WnaT = (bf16*)(ws + WS_WNA); bf16* WgluT = (bf16*)(ws + WS_WGLU);
    bf16* Ws5oT = (bf16*)(ws + WS_WS5O); bf16* WoutT = (bf16*)(ws + WS_WOUT); bf16* WguT = (bf16*)(ws + WS_WGU); bf16* WdnT = (bf16*)(ws + WS_WDN);
    int rr = it;
    if (rr < TI_IN) { const int kb = rr / 256, nb = rr % 256, n0 = 32 * nb;
        if (n0 >= 2048 && n0 < 3072) p0_transpose_item(args.in[1], D, 8192, WvT, n0 - 2048, kb, nb, scr, lane);
        else { const int orow = n0 < 2048 ? n0 : (n0 < 4096 ? 2048 + (n0 - 3072) : 3072 + (n0 - 4096)); p0_transpose_item(args.in[1], D, 8192, WinT, orow, kb, nb, scr, lane); }
        return; } rr -= TI_IN;
    if (rr < TI_NA) { p0_transpose_item(args.in[4], NAW, D, WnaT, 32 * (rr % 64), rr / 64, rr % 64, scr, lane); return; } rr -= TI_NA;
    if (rr < TI_GLU) { p0_transpose_item(args.in[13], S5W, S5W, WgluT, 32 * (rr % 32), rr / 32, rr % 32, scr, lane); return; } rr -= TI_GLU;
    if (rr < TI_S5O) { p0_transpose_item(args.in[15], S5W, D, Ws5oT, 32 * (rr % 64), rr / 64, rr % 64, scr, lane); return; } rr -= TI_S5O;
    if (rr < TI_OUT) { p0_transpose_item(args.in[16], D, D, WoutT, 32 * (rr % 64), rr / 64, rr % 64, scr, lane); return; } rr -= TI_OUT;
    if (rr < TI_FG) { const int nb = rr % 176, f0 = 32 * nb; p0_transpose_item(args.in[19], D, DFF, WguT, (f0 / 128) * 256 + (f0 % 128), rr / 176, nb, scr, lane); return; } rr -= TI_FG;
    if (rr < TI_FG) { const int nb = rr % 176, f0 = 32 * nb; p0_transpose_item(args.in[20], D, DFF, WguT, (f0 / 128) * 256 + 128 + (f0 % 128), rr / 176, nb, scr, lane); return; } rr -= TI_FG;
    p0_transpose_item(args.in[21], DFF, D, WdnT, 32 * (rr % 64), rr / 64, rr % 64, scr, lane);
}

__global__ void __launch_bounds__(NTHR, 2) mk_fwd(Args args) {
    extern __shared__ __attribute__((aligned(16))) unsigned char lds_raw[];
    LAS unsigned char* lds = (LAS unsigned char*)lds_raw;
    cg::grid_group grid = cg::this_grid();
    const int tid = threadIdx.x, lane = tid & 63, wave = __builtin_amdgcn_readfirstlane(tid >> 6);
    const int G = gridDim.x, bx = blockIdx.x;
    const int vcu = (G % 8 == 0) ? (bx % 8) * (G / 8) + bx / 8 : bx;
    const int gw = vcu * NWAVES + wave, NGW = G * NWAVES;
    unsigned char* ws = args.ws;
    const int lo = args.ph_lo, hi = args.ph_hi;
    volatile LAS unsigned* MISC = (volatile LAS unsigned*)(lds + LDS_BYTES - 128);
    if (tid < 32) MISC[tid] = 0u;
    __syncthreads();
    const XcdBarrier xbar = xcd_barrier_post((unsigned*)(ws + WS_CTL), MISC + 8);
    if (lo < 0) grid.sync();
#define IN(k) (lo <= (k) && (k) < hi)
#define SEAM(k) do { if (IN(k) && IN((k) + 1)) xcd_barrier(xbar); } while (0)
    const float* x = args.in[0];
    bf16* WinT = (bf16*)(ws + WS_WIN); bf16* WvT = (bf16*)(ws + WS_WV); bf16* WnaT = (bf16*)(ws + WS_WNA); bf16* WgluT = (bf16*)(ws + WS_WGLU);
    bf16* Ws5oT = (bf16*)(ws + WS_WS5O); bf16* WoutT = (bf16*)(ws + WS_WOUT); bf16* WguT = (bf16*)(ws + WS_WGU); bf16* WdnT = (bf16*)(ws + WS_WDN);
    bf16* XB = (bf16*)(ws + WS_XB); bf16* Qb = (bf16*)(ws + WS_Q); bf16* Kb = (bf16*)(ws + WS_K); bf16* VTb = (bf16*)(ws + WS_VT); bf16* Ub = (bf16*)(ws + WS_U);
    unsigned char* GAb = ws + WS_GA; unsigned char* GSb = ws + WS_GS; bf16* ATT = (bf16*)(ws + WS_ATT); bf16* YS = (bf16*)(ws + WS_YS); bf16* YS2 = (bf16*)(ws + WS_YS2);
    bf16* GATED = (bf16*)(ws + WS_GATED); bf16* PRE1 = (bf16*)(ws + WS_PRE1); bf16* PRE2 = (bf16*)(ws + WS_PRE2); bf16* HH = (bf16*)(ws + WS_HH); bf16* HB = (bf16*)(ws + WS_HB); bf16* ACT = (bf16*)(ws + WS_ACT);

    if (IN(0)) {
        LAS float* scr = (LAS float*)(lds + wave * 16384);
        for (int it = gw; it < TI_IN; it += NGW) transpose_item_any(args, ws, it, scr, lane);
        const int gt = vcu * NTHR + tid, NT = G * NTHR;
        for (int i8 = gt; i8 < M * D / 8; i8 += 4 * NT) {
            f32x4 a[4], b[4];
#pragma unroll
            for (int u = 0; u < 4; ++u) { const size_t j8 = (size_t)i8 + (size_t)u * NT < (size_t)M * D / 8 ? (size_t)i8 + (size_t)u * NT : (size_t)i8; a[u] = __builtin_nontemporal_load((const f32x4*)x + 2 * j8); b[u] = __builtin_nontemporal_load((const f32x4*)x + 2 * j8 + 1); }
#pragma unroll
            for (int u = 0; u < 4; ++u) { v4u o; o.x = cvt_pk_bf16(a[u][0], a[u][1]); o.y = cvt_pk_bf16(a[u][2], a[u][3]); o.z = cvt_pk_bf16(b[u][0], b[u][1]); o.w = cvt_pk_bf16(b[u][2], b[u][3]);
                if ((size_t)i8 + (size_t)u * NT < (size_t)M * D / 8) ((v4u*)XB)[i8 + u * NT] = o; }
        }
        float* LAMB = (float*)(ws + WS_LAMB); bf16* BMAT = (bf16*)(ws + WS_BMAT); unsigned* CMAT = (unsigned*)(ws + WS_CMAT);
        for (int idx = gt; idx < 2 * 64 * 64; idx += NT) {
            const int dgi = idx >> 6, p = idx & 63;
            const double are = (double)args.in[5][idx], aim = (double)args.in[6][idx];
            const double dt = dexp_small((double)args.in[7][dgi]);
            const double er = dexp_small(are * dt); double sn, cs; dsincos_small(aim * dt, sn, cs);
            const double lbr = er * cs, lbi = er * sn;
            LAMB[idx * 2] = (float)lbr; LAMB[idx * 2 + 1] = (float)lbi;
            const double nr = lbr - 1.0, ni = lbi, den = are * are + aim * aim;
            const double cr = (nr * are + ni * aim) / den, ci = (ni * are - nr * aim) / den;
            const float* bre = args.in[8] + (size_t)idx * 16; const float* bim = args.in[9] + (size_t)idx * 16;
#pragma unroll
            for (int c2 = 0; c2 < 16; c2 += 2) {
                const double br0 = bre[c2], bi0 = bim[c2], br1 = bre[c2 + 1], bi1 = bim[c2 + 1];
                *(unsigned*)(BMAT + ((size_t)dgi * 128 + p) * 16 + c2) = cvt_pk_bf16((float)(cr * br0 - ci * bi0), (float)(cr * br1 - ci * bi1));
                *(unsigned*)(BMAT + ((size_t)dgi * 128 + 64 + p) * 16 + c2) = cvt_pk_bf16((float)(cr * bi0 + ci * br0), (float)(cr * bi1 + ci * br1));
            }
        }
        for (int idx = gt; idx < 2 * 64 * 16 * 64; idx += NT) CMAT[idx] = cvt_pk_bf16(args.in[10][idx], -args.in[11][idx]);
    }
    SEAM(0);

    if (IN(1)) {
        { pg8::Gemm g{XB, WinT, M, NPROJ, D}; pg8::StaticOrder S; S.init(M, NPROJ, G, bx, 4);
          pg8::EpiProj E{Qb, Kb, Ub, GAb, GSb, args.in[2], QSCALE};
          pg8::gemm_phase<pg8::EpiProj, pg8::StaticOrder, true, true>(lds, g, S, E); }
        { pg8::Gemm g{WvT, XB, NAW, M, D}; pg8::StaticOrder S; S.init(NAW, M, G, bx);
          pg8::EpiPlain E{VTb, M};
          pg8::gemm_phase<pg8::EpiPlain, pg8::StaticOrder, true, true>(lds, g, S, E); }
    }
    SEAM(1);

    if (IN(2)) {
        if (NGW == 2048) {
            const int dir = gw & 1, g = (gw >> 1) & 63, sp = gw >> 7;
            s5_pass1_pair(ws, Ub, sp, sp + 16, g, dir, lane);
        } else
        for (int it = gw; it < (NS / 2) * 64 * 2; it += NGW) { const int dir = it & 1, g = (it >> 1) & 63, sp = it >> 7;
            s5_run<false>(ws, Ub, sp, g, dir, lds, lane, nullptr, nullptr, nullptr); }
        __syncthreads();
        for (int it = vcu; it < (NROWS / 4) * NH; it += G) attn_block(Qb, Kb, VTb, ATT, args.in[3], it >> 3, it & 7, lds, wave, lane, tid);
    }
    SEAM(2);

    if (IN(3)) {
        LAS unsigned char* wl = lds + wave * 8704;
        LAS float* scr3 = (LAS float*)(lds + 73728 + wave * 8448);
        if (wave >= 4) { for (int it = TI_IN + gw; it < TI_ALL; it += NGW) transpose_item_any(args, ws, it, scr3, lane); }
        for (int it = gw; it < (NS / 2) * 64; it += NGW) { const int g = it & 63, sp = it >> 6;
            s5_run<true>(ws, Ub, sp, g, 0, wl, lane, args.out, YS, args.in[12]);
            s5_run<true>(ws, Ub, sp, g, 1, wl, lane, args.out, YS, args.in[12]); }
        if (wave < 4) { for (int it = TI_IN + gw; it < TI_ALL; it += NGW) transpose_item_any(args, ws, it, scr3, lane); }
        __syncthreads();
    }
    SEAM(3);

    if (IN(4)) {
        pg8::Gemm g{YS, WgluT, M, S5W, S5W}; pg8::StaticOrder S; S.init(M, S5W, G, bx);
        pg8::EpiGlu E{YS, YS2, S5W, args.in[14]};
        pg8::gemm_phase<pg8::EpiGlu, pg8::StaticOrder, true, true>(lds, g, S, E);
    }
    SEAM(4);

    if (IN(5)) {
        pg8::Gemm g{ATT, WnaT, M, D, NAW, YS2, Ws5oT}; pg8::PairOrder S; S.s.init(M, D, G, bx, 4);
        pg8::EpiMixChain E{GAb, GSb, GATED, D};
        pg8::gemm_phase<pg8::EpiMixChain, pg8::PairOrder, true, true>(lds, g, S, E);
    }
    SEAM(5);

    if (IN(6)) {
        pg8::Gemm g{GATED, WoutT, M, D, D}; pg8::StaticOrder S; S.init(M, D, G, bx, 4);
        pg8::EpiResF E{x, PRE1, D, ALPHA};
        pg8::gemm_phase<pg8::EpiResF, pg8::StaticOrder, true, true>(lds, g, S, E);
    }
    SEAM(6);

    if (IN(7)) ln_phase(PRE1, nullptr, HB, nullptr, args.in[17], args.in[18], gw, NGW, lane);
    SEAM(7);

    if (IN(8)) {
        pg8::Gemm g{HB, WguT, M, 2 * DFF, D}; pg8::StaticOrder S; S.init(M, 2 * DFF, G, bx, 4, 1);
        pg8::EpiFfn E{ACT, DFF};
        pg8::gemm_phase<pg8::EpiFfn, pg8::StaticOrder, true, true>(lds, g, S, E);
    }
    SEAM(8);

    if (IN(9)) {
        pg8::Gemm g{ACT, WdnT, M, D, DFF}; pg8::StaticOrder S; S.init(M, D, G, bx, 4);
        pg8::EpiResB E{HB, PRE2, D, ALPHA};
        pg8::gemm_phase<pg8::EpiResB, pg8::StaticOrder, true, true>(lds, g, S, E);
    }
    SEAM(9);

    if (IN(10)) ln_phase(PRE2, args.out, nullptr, nullptr, args.in[22], args.in[23], gw, NGW, lane);
#undef IN
#undef SEAM
}

#ifndef MK_DUP
#define MK_DUP 0
#endif
#ifndef MK_N_LAUNCHES
#define MK_N_LAUNCHES 1
#endif
constexpr int NPHASES = 11;

extern "C" void kernel_launch(void* const* d_in, const int* in_sizes, int n_in, void* d_out, int out_size, void* d_ws, size_t ws_size, hipStream_t stream) {
    static int grid = 0;
    if (grid == 0) {
        if (n_in != 24 || in_sizes[0] != M * D || out_size != M * D || ws_size < WS_END) { fprintf(stderr, "kernel_launch: unexpected shapes (n_in %d, in0 %d, out %d, ws %zu)\n", n_in, n_in > 0 ? in_sizes[0] : -1, out_size, ws_size); grid = -1; return; }
        int dev = 0, cus = 0, per_cu = 0;
        if (hipGetDevice(&dev) != hipSuccess || hipDeviceGetAttribute(&cus, hipDeviceAttributeMultiprocessorCount, dev) != hipSuccess) { grid = -1; return; }
        if (hipFuncSetAttribute((const void*)mk_fwd, hipFuncAttributeMaxDynamicSharedMemorySize, LDS_BYTES) != hipSuccess) { fprintf(stderr, "kernel_launch: hipFuncSetAttribute failed\n"); grid = -1; return; }
        if (hipOccupancyMaxActiveBlocksPerMultiprocessor(&per_cu, (const void*)mk_fwd, NTHR, LDS_BYTES) != hipSuccess || per_cu < 1) { fprintf(stderr, "kernel_launch: occupancy query says %d\n", per_cu); per_cu = 1; }
        (void)hipGetLastError();
        grid = cus;
    }
    if (grid < 0) return;
    if (hipMemsetAsync((char*)d_ws + WS_CTL, 0, CTL_ZERO_BYTES, stream) != hipSuccess) { fprintf(stderr, "kernel_launch: memset of the barrier words failed\n"); return; }
    Args a{};
    for (int i = 0; i < 24; ++i) a.in[i] = (const float*)d_in[i];
    a.out = (float*)d_out; a.ws = (unsigned char*)d_ws;
    if (MK_N_LAUNCHES == 1) {
        a.ph_lo = 0; a.ph_hi = NPHASES;
        void* kargs[] = {&a};
        hipError_t e = hipLaunchCooperativeKernel((const void*)mk_fwd, dim3(grid), dim3(NTHR), kargs, LDS_BYTES, stream);
        if (e != hipSuccess) fprintf(stderr, "kernel_launch: cooperative launch failed: %s (grid %d)\n", hipGetErrorString(e), grid);
    } else {
        for (int p = 0; p < NPHASES; ++p) { a.ph_lo = p; a.ph_hi = p + 1;
            const int reps = ((MK_DUP >> p) & 1) ? 2 : 1;
            for (int q = 0; q < reps; ++q) hipLaunchKernelGGL(mk_fwd, dim3(grid), dim3(NTHR), LDS_BYTES, stream, a); }
    }
}
```
